# Optimizing an MI355X kernel written in HIP

```python
import math
import jax, jax.numpy as jnp
from jax import lax
import numpy as np

D_MODEL = 1024
BATCH = 1
SEQ = 16384
DEPTH = 2
DEC_BATCH = 16
DEC_SEQ = 2048
PAST_LEN = 128

CONV_W = 512
CONV_K = 31
N_HEADS = 8
HEAD_DIM = 64
ATTN_W = N_HEADS * 2 * HEAD_DIM
Q_BLOCK = 128
ROPE_THETA = 10000.0
SGU_W = 512
SGU_GROUPS = 4
SGU_GROUP_W = SGU_W // SGU_GROUPS
CHUNK = 128
N_BRANCH = 3
RMS_EPS = 1e-6

_COLS = (
    2 * CONV_W,
    CONV_W,
    ATTN_W,
    ATTN_W,
    ATTN_W,
    ATTN_W,
    SGU_W,
    SGU_W,
    SGU_W,
    N_BRANCH * D_MODEL,
)
IN_COLS = sum(_COLS)
SPLITS = tuple(int(s) for s in np.cumsum(_COLS)[:-1])

kernel_name = "hybrid_conv_diffattn_gmlp_encoder"


def lambda_init_fn(layer_idx):
    return 0.8 - 0.6 * math.exp(-0.3 * layer_idx)


def rmsnorm(x, g):
    xf = x.astype(jnp.float32)
    y = xf * lax.rsqrt(jnp.mean(xf * xf, axis=-1, keepdims=True) + RMS_EPS)
    return (y * g.astype(jnp.float32)).astype(x.dtype)


def rotary(x, pos):
    half = HEAD_DIM // 2
    inv = ROPE_THETA ** (-jnp.arange(half, dtype=jnp.float32) / half)
    ang = pos.astype(jnp.float32)[:, None] * inv[None, :]
    cos = jnp.cos(ang)[None, :, None, None, :]
    sin = jnp.sin(ang)[None, :, None, None, :]
    xf = x.astype(jnp.float32)
    x1, x2 = xf[..., :half], xf[..., half:]
    out = jnp.concatenate([x1 * cos - x2 * sin, x2 * cos + x1 * sin], axis=-1)
    return out.astype(x.dtype)


def depthwise_conv(x, w, b):
    c = x.shape[-1]
    y = lax.conv_general_dilated(
        x, w[:, None, :].astype(x.dtype), window_strides=(1,),
        padding=[(CONV_K // 2, CONV_K // 2)],
        dimension_numbers=("NWC", "WIO", "NWC"), feature_group_count=c)
    return y + b.astype(x.dtype)


def diff_attention(q, k, v, lam):
    b, s = q.shape[0], q.shape[1]
    nblk = s // Q_BLOCK
    scale = 1.0 / math.sqrt(HEAD_DIM)
    qb = q.reshape(b, nblk, Q_BLOCK, N_HEADS, 2, HEAD_DIM).transpose(1, 0, 2, 3, 4, 5)
    kf = k.astype(jnp.float32)
    vf = v.astype(jnp.float32)

    def block(qblk):
        sc = jnp.einsum("bqhcd,bkhcd->bchqk", qblk.astype(jnp.float32), kf) * scale
        p = jax.nn.softmax(sc, axis=-1)
        a = p[:, 0] - lam * p[:, 1]
        return jnp.einsum("bhqk,bkhd->bqhd", a, vf)

    o = lax.map(block, qb)
    return o.transpose(1, 0, 2, 3, 4).reshape(b, s, N_HEADS, 2 * HEAD_DIM)


def mixer_layer(x, l, pos, norm_g, w_in, conv_w, conv_b, conv_norm_g, w_proj_a,
                lam_q1, lam_k1, lam_q2, lam_k2, subln_g, w_proj_b,
                sgu_norm_g, sgu_w, sgu_b, w_proj_c, w_out):
    b, s, _ = x.shape
    h = rmsnorm(x, norm_g)
    z = h @ w_in
    a_in, a_gate, q, k, v, b_gate, c_u, c_v, c_gate, merge = jnp.split(z, SPLITS, axis=-1)

    a = a_in[..., :CONV_W] * jax.nn.sigmoid(a_in[..., CONV_W:])
    a = depthwise_conv(a, conv_w, conv_b)
    a = jax.nn.silu(rmsnorm(a, conv_norm_g))
    ya = (a * jax.nn.silu(a_gate)) @ w_proj_a

    lam_init = lambda_init_fn(l)
    q = rotary(q.reshape(b, s, N_HEADS, 2, HEAD_DIM), pos)
    k = rotary(k.reshape(b, s, N_HEADS, 2, HEAD_DIM), pos)
    v = v.reshape(b, s, N_HEADS, 2 * HEAD_DIM)
    lam = (jnp.exp(jnp.sum(lam_q1.astype(jnp.float32) * lam_k1.astype(jnp.float32)))
           - jnp.exp(jnp.sum(lam_q2.astype(jnp.float32) * lam_k2.astype(jnp.float32)))
           + lam_init)
    o = diff_attention(q, k, v, lam)
    o = rmsnorm(o, subln_g) * (1.0 - lam_init)
    yb = (o.reshape(b, s, ATTN_W).astype(x.dtype) * jax.nn.silu(b_gate)) @ w_proj_b

    cv = rmsnorm(c_v, sgu_norm_g).reshape(b, s // CHUNK, CHUNK, SGU_GROUPS, SGU_GROUP_W)
    mixed = jnp.einsum("gpq,bnqgd->bnpgd", sgu_w, cv) + sgu_b.T[None, None, :, :, None]
    yc = (c_u * mixed.reshape(b, s, SGU_W) * jax.nn.silu(c_gate)) @ w_proj_c

    m = jax.nn.sigmoid(merge).reshape(b, s, N_BRANCH, D_MODEL)
    y = m[:, :, 0] * ya + m[:, :, 1] * yb + m[:, :, 2] * yc
    return x + y @ w_out


def trunk(x, norm_g, w_in, conv_w, conv_b, conv_norm_g, w_proj_a,
          lam_q1, lam_k1, lam_q2, lam_k2, subln_g, w_proj_b,
          sgu_norm_g, sgu_w, sgu_b, w_proj_c, w_out, final_g):
    pos = jnp.arange(x.shape[1], dtype=jnp.int32)
    for l in range(DEPTH):
        x = mixer_layer(x, l, pos, norm_g[l], w_in[l], conv_w[l], conv_b[l], conv_norm_g[l], w_proj_a[l],
                        lam_q1[l], lam_k1[l], lam_q2[l], lam_k2[l], subln_g[l], w_proj_b[l],
                        sgu_norm_g[l], sgu_w[l], sgu_b[l], w_proj_c[l], w_out[l])
    return rmsnorm(x, final_g)


def setup_inputs(seed: int = 0) -> dict:
    key = jax.random.key(seed)
    ks = jax.random.split(key, 22)
    f32 = jnp.float32

    def nrm(k, shape, scale):
        return jax.random.normal(k, shape, f32) * scale

    return {
        "x_prompt": nrm(ks[0], (BATCH, SEQ, D_MODEL), 1.0),
        "x_sample": nrm(ks[1], (DEC_BATCH, DEC_SEQ, D_MODEL), 1.0),
        "norm_g": 1.0 + nrm(ks[2], (DEPTH, D_MODEL), 0.02),
        "w_in": nrm(ks[3], (DEPTH, D_MODEL, IN_COLS), D_MODEL ** -0.5),
        "conv_w": nrm(ks[4], (DEPTH, CONV_K, CONV_W), CONV_K ** -0.5),
        "conv_b": nrm(ks[5], (DEPTH, CONV_W), 0.02),
        "conv_norm_g": 1.0 + nrm(ks[6], (DEPTH, CONV_W), 0.02),
        "w_proj_a": nrm(ks[7], (DEPTH, CONV_W, D_MODEL), CONV_W ** -0.5),
        "lam_q1": nrm(ks[8], (DEPTH, HEAD_DIM), 0.1),
        "lam_k1": nrm(ks[9], (DEPTH, HEAD_DIM), 0.1),
        "lam_q2": nrm(ks[10], (DEPTH, HEAD_DIM), 0.1),
        "lam_k2": nrm(ks[11], (DEPTH, HEAD_DIM), 0.1),
        "subln_g": 1.0 + nrm(ks[12], (DEPTH, 2 * HEAD_DIM), 0.02),
        "w_proj_b": nrm(ks[13], (DEPTH, ATTN_W, D_MODEL), ATTN_W ** -0.5),
        "sgu_norm_g": 1.0 + nrm(ks[14], (DEPTH, SGU_W), 0.02),
        "sgu_w": nrm(ks[15], (DEPTH, SGU_GROUPS, CHUNK, CHUNK), CHUNK ** -0.5),
        "sgu_b": 1.0 + nrm(ks[16], (DEPTH, SGU_GROUPS, CHUNK), 0.02),
        "w_proj_c": nrm(ks[17], (DEPTH, SGU_W, D_MODEL), SGU_W ** -0.5),
        "w_out": nrm(ks[18], (DEPTH, D_MODEL, D_MODEL), D_MODEL ** -0.5),
        "final_g": 1.0 + nrm(ks[19], (D_MODEL,), 0.02),
    }


def reference(x_prompt, x_sample, norm_g, w_in, conv_w, conv_b, conv_norm_g, w_proj_a,
              lam_q1, lam_k1, lam_q2, lam_k2, subln_g, w_proj_b,
              sgu_norm_g, sgu_w, sgu_b, w_proj_c, w_out, final_g):
    y_prompt = trunk(x_prompt, norm_g, w_in, conv_w, conv_b, conv_norm_g, w_proj_a,
                     lam_q1, lam_k1, lam_q2, lam_k2, subln_g, w_proj_b,
                     sgu_norm_g, sgu_w, sgu_b, w_proj_c, w_out, final_g)
    y_sample = trunk(x_sample, norm_g, w_in, conv_w, conv_b, conv_norm_g, w_proj_a,
                     lam_q1, lam_k1, lam_q2, lam_k2, subln_g, w_proj_b,
                     sgu_norm_g, sgu_w, sgu_b, w_proj_c, w_out, final_g)
    return (y_prompt, y_sample)
```

```cpp
#include <hip/hip_runtime.h>
#include <hip/hip_cooperative_groups.h>
#include <cstdio>
#include <cstdint>
#include <cmath>
namespace pg8 {
#define PG8_LAS __attribute__((address_space(3)))
typedef unsigned short bf16_t;
typedef short bf16x8 __attribute__((ext_vector_type(8)));
typedef float f32x4 __attribute__((ext_vector_type(4)));
typedef unsigned u32x4 __attribute__((ext_vector_type(4)));
constexpr int BM = 256, BK = 64, HALF = 128, HTB = HALF * BK * 2  , STAGE_BYTES = 8 * HTB, NXCD = 8, WGM = 2;

__host__ __device__ __forceinline__ int lds_byte(int r, int c) { const int st = (r >> 4) * 2 + (c >> 5), rr = r & 15, cc = c & 31, ob = rr * 64 + cc * 2; return st * 1024 + (ob ^ (((ob >> 9) & 1) << 5)); }
__host__ __device__ __forceinline__ void stage_rc(int b, int& R, int& C) { const int st = b / 1024, sb = b % 1024, swz = sb ^ (((sb >> 9) & 1) << 5); R = (st >> 1) * 16 + swz / 64; C = (st & 1) * 32 + (swz % 64) / 2; }
__host__ __device__ __forceinline__ int perm32(int rho) { const int n = rho >> 4, i = rho & 15; return 8 * (i >> 2) + 4 * n + (i & 3); }

struct Unit { int pm, pn, seg; };
struct Gemm { const bf16_t* A; const bf16_t* Bt; int M, N, K; };

struct StaticOrder {
    int nM, nN, nwg, G, c;
    __host__ __device__ void init(int M, int N, int G_, int c_) { nM = M / BM; nN = N / BM; nwg = nM * nN; G = G_; c = c_; }
    __host__ __device__ bool next(int i, Unit& u) const {
        const long L = (long)i * G + c; if (L >= nwg) return false;
        int wgid = (int)L; { const int q = nwg / NXCD, r = nwg % NXCD, xcd = wgid % NXCD, off = wgid / NXCD; wgid = (xcd < r ? xcd * (q + 1) : r * (q + 1) + (xcd - r) * q) + off; }
        const int nig = WGM * nN, gid = wgid / nig, fm = gid * WGM, gsz = (nM - fm) < WGM ? (nM - fm) : WGM;
        u.pm = fm + ((wgid % nig) % gsz); u.pn = (wgid % nig) / gsz; return true;
    }
    __device__ __forceinline__ void a_ready(const Unit&) const {}
    __device__ __forceinline__ void done(const Unit&) const {}
};

__device__ __forceinline__ unsigned cvt_pk_bf16(float lo, float hi) { unsigned r; asm volatile("v_cvt_pk_bf16_f32 %0, %1, %2" : "=v"(r) : "v"(lo), "v"(hi)); return r; }
template <class Epi, class Sched, bool ALIGN_EPI = false, bool SP2 = false>
__device__ __forceinline__ void gemm_phase(PG8_LAS unsigned char* lds, const Gemm g, const Sched& S, const Epi& E, const int tid_in) {
    const int tid = tid_in, wid = __builtin_amdgcn_readfirstlane(tid >> 6), lane = tid & 63, wr = wid >> 2, wc = wid & 3, fr = lane & 15, fq = lane >> 4;
    const int K = g.K, nt = K / BK;
    unsigned voffA[2], voffB[2];
#pragma unroll
    for (int i = 0; i < 2; ++i) { int R, C; stage_rc(tid * 16 + i * 8192, R, C); const int Rb = Epi::PERM ? ((R & ~31) + perm32(R & 31)) : R;
        voffA[i] = (unsigned)(R * K + C) * 2u; voffB[i] = (unsigned)(Rb * K + C) * 2u; }
    const size_t kstep = (size_t)(BK * 2);
    const size_t hstep = (size_t)HALF * K * 2;
    const size_t tstep = 2 * hstep;
    const unsigned ldsw = (unsigned)wid * 1024u;
    const int aoff = lds_byte(wr * 64 + fr, fq * 8), boff = lds_byte(wc * 32 + fr, fq * 8);
#define PG8_SA(b, h) (((b) * 2 + (h)) * HTB)
#define PG8_SB(b, h) ((4 + (b) * 2 + (h)) * HTB)
#define PG8_STAGE(bufoff, gbase, voff) do { _Pragma("unroll") for (int _i = 0; _i < 2; ++_i) \
        __builtin_amdgcn_global_load_lds((const unsigned*)((const char*)(gbase) + (voff)[_i]), (PG8_LAS unsigned*)(lds + (bufoff) + ldsw + _i * 8192), 16, 0, 0); } while (0)
#define PG8_LDA(dst, b, h) do { _Pragma("unroll") for (int m = 0; m < 4; ++m) _Pragma("unroll") for (int k = 0; k < 2; ++k) dst[m][k] = *(const PG8_LAS bf16x8*)(lds + PG8_SA(b, h) + aoff + m * 2048 + k * 1024); } while (0)
#define PG8_LDB(dst, b, h) do { _Pragma("unroll") for (int n = 0; n < 2; ++n) _Pragma("unroll") for (int k = 0; k < 2; ++k) dst[n][k] = *(const PG8_LAS bf16x8*)(lds + PG8_SB(b, h) + boff + n * 2048 + k * 1024); } while (0)
#define PG8_MMA(ai, bj, At, Bt) do { __builtin_amdgcn_s_setprio(1); _Pragma("unroll") for (int m = 0; m < 4; ++m) _Pragma("unroll") for (int n = 0; n < 2; ++n) _Pragma("unroll") for (int k = 0; k < 2; ++k) \
        acc[ai][bj][m][n] = __builtin_amdgcn_mfma_f32_16x16x32_bf16(Bt[n][k], At[m][k], acc[ai][bj][m][n], 0, 0, 0); __builtin_amdgcn_s_setprio(0); } while (0)
#define PG8_WAIT_V(n) asm volatile("s_waitcnt vmcnt(" #n ")" ::: "memory")
#define PG8_WAIT_L(n) asm volatile("s_waitcnt lgkmcnt(" #n ")" ::: "memory")
#define PG8_BAR __builtin_amdgcn_s_barrier()
#define PG8_SCHED __builtin_amdgcn_sched_barrier(0)
    Unit cur, nxt; int ui = 0;
    if (!S.next(0, cur)) return;
    f32x4 acc[2][2][4][2];
#pragma unroll
    for (int a = 0; a < 2; ++a)
#pragma unroll
        for (int b = 0; b < 2; ++b)
#pragma unroll
            for (int m = 0; m < 4; ++m)
#pragma unroll
                for (int n = 0; n < 2; ++n) acc[a][b][m][n] = (f32x4){0.f, 0.f, 0.f, 0.f};
    bf16x8 At[4][2], B0[2][2], B1[2][2];
    const char* cA = (const char*)g.A + (size_t)cur.pm * tstep; const char* cB = (const char*)g.Bt + (size_t)cur.pn * tstep;
    S.a_ready(cur);
    if constexpr (SP2) {
        PG8_STAGE(PG8_SB(0, 0), cB, voffB); PG8_STAGE(PG8_SB(0, 1), cB + hstep, voffB); PG8_STAGE(PG8_SA(0, 0), cA, voffA); PG8_STAGE(PG8_SA(0, 1), cA + hstep, voffA);
        if (wr == 1) PG8_BAR;
        PG8_WAIT_V(2); PG8_BAR;
        PG8_STAGE(PG8_SB(1, 0), cB + kstep, voffB); PG8_STAGE(PG8_SA(1, 0), cA + kstep, voffA); PG8_STAGE(PG8_SB(1, 1), cB + hstep + kstep, voffB);
        PG8_WAIT_V(6); PG8_BAR;
    } else {
        PG8_STAGE(PG8_SB(0, 0), cB, voffB); PG8_STAGE(PG8_SA(0, 0), cA, voffA); PG8_STAGE(PG8_SB(0, 1), cB + hstep, voffB); PG8_STAGE(PG8_SA(0, 1), cA + hstep, voffA);
        if (wr == 1) PG8_BAR;
        PG8_WAIT_V(4); PG8_BAR;
        PG8_STAGE(PG8_SB(1, 0), cB + kstep, voffB); PG8_STAGE(PG8_SA(1, 0), cA + kstep, voffA); PG8_STAGE(PG8_SB(1, 1), cB + hstep + kstep, voffB);
        PG8_WAIT_V(6); PG8_BAR;
    }
    for (;;) {
        const bool has_next = S.next(ui + 1, nxt);
        const char* nA = has_next ? (const char*)g.A + (size_t)nxt.pm * tstep : cA; const char* nB = has_next ? (const char*)g.Bt + (size_t)nxt.pn * tstep : cB;
        for (int t = 0; t < nt; t += 2) {
            const bool last = (t == nt - 2);
            const char* a1 = cA + (size_t)(t + 1) * kstep;
            const char* a2 = last ? nA : cA + (size_t)(t + 2) * kstep; const char* b2 = last ? nB : cB + (size_t)(t + 2) * kstep;
            const char* a3 = a2 + kstep; const char* b3 = b2 + kstep;
            if (last && has_next) S.a_ready(nxt);
            if constexpr (SP2) {
            PG8_LDB(B0, 0, 0); PG8_LDB(B1, 0, 1); PG8_SCHED; PG8_LDA(At, 0, 0); PG8_STAGE(PG8_SA(1, 1), a1 + hstep, voffA);
            PG8_WAIT_V(8); PG8_WAIT_L(0); PG8_BAR; PG8_MMA(0, 0, At, B0); PG8_MMA(0, 1, At, B1); PG8_BAR; PG8_SCHED;
            PG8_LDA(At, 0, 1); PG8_STAGE(PG8_SB(0, 0), b2, voffB); PG8_STAGE(PG8_SB(0, 1), b2 + hstep, voffB); PG8_STAGE(PG8_SA(0, 0), a2, voffA);
            PG8_WAIT_V(8); PG8_WAIT_L(0); PG8_BAR; PG8_MMA(1, 0, At, B0); PG8_MMA(1, 1, At, B1); PG8_BAR; PG8_SCHED;
            PG8_LDB(B0, 1, 0); PG8_LDB(B1, 1, 1); PG8_SCHED; PG8_LDA(At, 1, 0); PG8_STAGE(PG8_SA(0, 1), a2 + hstep, voffA);
            PG8_WAIT_V(8); PG8_WAIT_L(0); PG8_BAR; PG8_MMA(0, 0, At, B0); PG8_MMA(0, 1, At, B1); PG8_BAR; PG8_SCHED;
            PG8_LDA(At, 1, 1); PG8_STAGE(PG8_SB(1, 0), b3, voffB); PG8_STAGE(PG8_SB(1, 1), b3 + hstep, voffB); PG8_STAGE(PG8_SA(1, 0), a3, voffA);
            PG8_WAIT_V(8); PG8_WAIT_L(0); PG8_BAR; PG8_MMA(1, 0, At, B0); PG8_MMA(1, 1, At, B1); PG8_BAR; PG8_SCHED;
            } else {
            PG8_LDB(B0, 0, 0); PG8_SCHED; PG8_LDA(At, 0, 0); PG8_STAGE(PG8_SA(1, 1), a1 + hstep, voffA);
            PG8_WAIT_L(8); PG8_BAR; PG8_WAIT_L(0); PG8_MMA(0, 0, At, B0); PG8_BAR; PG8_SCHED;
            PG8_LDB(B1, 0, 1); PG8_STAGE(PG8_SB(0, 0), b2, voffB);
            PG8_BAR; PG8_WAIT_L(0); PG8_MMA(0, 1, At, B1); PG8_BAR;
            PG8_LDA(At, 0, 1); PG8_STAGE(PG8_SA(0, 0), a2, voffA);
            PG8_BAR; PG8_WAIT_L(0); PG8_MMA(1, 0, At, B0); PG8_BAR; PG8_SCHED;
            PG8_STAGE(PG8_SB(0, 1), b2 + hstep, voffB);
            PG8_WAIT_V(6); PG8_BAR; PG8_MMA(1, 1, At, B1); PG8_BAR;
            PG8_LDB(B0, 1, 0); PG8_SCHED; PG8_LDA(At, 1, 0); PG8_STAGE(PG8_SA(0, 1), a2 + hstep, voffA);
            PG8_WAIT_L(8); PG8_BAR; PG8_WAIT_L(0); PG8_MMA(0, 0, At, B0); PG8_BAR; PG8_SCHED;
            PG8_LDB(B1, 1, 1); PG8_STAGE(PG8_SB(1, 0), b3, voffB);
            PG8_BAR; PG8_WAIT_L(0); PG8_MMA(0, 1, At, B1); PG8_BAR;
            PG8_LDA(At, 1, 1); PG8_STAGE(PG8_SA(1, 0), a3, voffA);
            PG8_BAR; PG8_WAIT_L(0); PG8_MMA(1, 0, At, B0); PG8_BAR; PG8_SCHED;
            PG8_STAGE(PG8_SB(1, 1), b3 + hstep, voffB);
            PG8_WAIT_V(6); PG8_BAR; PG8_MMA(1, 1, At, B1); PG8_BAR;
            }
        }
        if constexpr (ALIGN_EPI) { if (wr == 0) PG8_BAR; }
        if constexpr (!Epi::AFTER_DRAIN) { E(acc, cur, wr, wc, fr, fq); S.done(cur); }
        if (!has_next) break;
#pragma unroll
        for (int a = 0; a < 2; ++a)
#pragma unroll
            for (int b = 0; b < 2; ++b)
#pragma unroll
                for (int m = 0; m < 4; ++m)
#pragma unroll
                    for (int n = 0; n < 2; ++n) acc[a][b][m][n] = (f32x4){0.f, 0.f, 0.f, 0.f};
        cur = nxt; cA = nA; cB = nB; ++ui;
        if constexpr (ALIGN_EPI) { if (wr == 1) PG8_BAR; }
    }
    PG8_WAIT_V(0);
    if constexpr (!ALIGN_EPI) { if (wr == 0) PG8_BAR; }
    PG8_BAR;
    if constexpr (Epi::AFTER_DRAIN) { E.fused(acc, cur, wr, wc, fr, fq, lds, wid, lane); S.done(cur); }
#undef PG8_SA
#undef PG8_SB
#undef PG8_STAGE
#undef PG8_LDA
#undef PG8_LDB
#undef PG8_MMA
#undef PG8_WAIT_V
#undef PG8_WAIT_L
#undef PG8_BAR
#undef PG8_SCHED
}
template <class Epi, class Sched, bool ALIGN_EPI = false, bool SP2 = false>
__device__ __forceinline__ void gemm_phase_seg(PG8_LAS unsigned char* lds, const Gemm g, const Sched& S, const Epi& E, const int tid_in) {
    const int tid = tid_in, wid = __builtin_amdgcn_readfirstlane(tid >> 6), lane = tid & 63, wr = wid >> 2, wc = wid & 3, fr = lane & 15, fq = lane >> 4;
    const int K = g.K; int nt;
    unsigned voffA[2], voffB[2];
#pragma unroll
    for (int i = 0; i < 2; ++i) { int R, C; stage_rc(tid * 16 + i * 8192, R, C); const int Rb = Epi::PERM ? ((R & ~31) + perm32(R & 31)) : R;
        voffA[i] = (unsigned)(R * K + C) * 2u; voffB[i] = (unsigned)(Rb * K + C) * 2u; }
    const size_t kstep = (size_t)(BK * 2);
    const size_t hstep = (size_t)HALF * K * 2;
    const size_t tstep = 2 * hstep;
    const unsigned ldsw = (unsigned)wid * 1024u;
    const int aoff = lds_byte(wr * 64 + fr, fq * 8), boff = lds_byte(wc * 32 + fr, fq * 8);
#define PG8_SA(b, h) (((b) * 2 + (h)) * HTB)
#define PG8_SB(b, h) ((4 + (b) * 2 + (h)) * HTB)
#define PG8_STAGE(bufoff, gbase, voff) do { _Pragma("unroll") for (int _i = 0; _i < 2; ++_i) \
        __builtin_amdgcn_global_load_lds((const unsigned*)((const char*)(gbase) + (voff)[_i]), (PG8_LAS unsigned*)(lds + (bufoff) + ldsw + _i * 8192), 16, 0, 0); } while (0)
#define PG8_LDA(dst, b, h) do { _Pragma("unroll") for (int m = 0; m < 4; ++m) _Pragma("unroll") for (int k = 0; k < 2; ++k) dst[m][k] = *(const PG8_LAS bf16x8*)(lds + PG8_SA(b, h) + aoff + m * 2048 + k * 1024); } while (0)
#define PG8_LDB(dst, b, h) do { _Pragma("unroll") for (int n = 0; n < 2; ++n) _Pragma("unroll") for (int k = 0; k < 2; ++k) dst[n][k] = *(const PG8_LAS bf16x8*)(lds + PG8_SB(b, h) + boff + n * 2048 + k * 1024); } while (0)
#define PG8_MMA(ai, bj, At, Bt) do { __builtin_amdgcn_s_setprio(1); _Pragma("unroll") for (int m = 0; m < 4; ++m) _Pragma("unroll") for (int n = 0; n < 2; ++n) _Pragma("unroll") for (int k = 0; k < 2; ++k) \
        acc[ai][bj][m][n] = __builtin_amdgcn_mfma_f32_16x16x32_bf16(Bt[n][k], At[m][k], acc[ai][bj][m][n], 0, 0, 0); __builtin_amdgcn_s_setprio(0); } while (0)
#define PG8_WAIT_V(n) asm volatile("s_waitcnt vmcnt(" #n ")" ::: "memory")
#define PG8_WAIT_L(n) asm volatile("s_waitcnt lgkmcnt(" #n ")" ::: "memory")
#define PG8_BAR __builtin_amdgcn_s_barrier()
#define PG8_SCHED __builtin_amdgcn_sched_barrier(0)
    Unit cur, nxt; int ui = 0;
    if (!S.next(0, cur)) return;
    f32x4 acc[2][2][4][2];
#pragma unroll
    for (int a = 0; a < 2; ++a)
#pragma unroll
        for (int b = 0; b < 2; ++b)
#pragma unroll
            for (int m = 0; m < 4; ++m)
#pragma unroll
                for (int n = 0; n < 2; ++n) acc[a][b][m][n] = (f32x4){0.f, 0.f, 0.f, 0.f};
    bf16x8 At[4][2], B0[2][2], B1[2][2];
    const char* cA = S.aptr(cur, tstep); const char* cB = S.bptr(cur, tstep); nt = S.nt(cur);
    S.a_ready(cur);
    if constexpr (SP2) {
        PG8_STAGE(PG8_SB(0, 0), cB, voffB); PG8_STAGE(PG8_SB(0, 1), cB + hstep, voffB); PG8_STAGE(PG8_SA(0, 0), cA, voffA); PG8_STAGE(PG8_SA(0, 1), cA + hstep, voffA);
        if (wr == 1) PG8_BAR;
        PG8_WAIT_V(2); PG8_BAR;
        PG8_STAGE(PG8_SB(1, 0), cB + kstep, voffB); PG8_STAGE(PG8_SA(1, 0), cA + kstep, voffA); PG8_STAGE(PG8_SB(1, 1), cB + hstep + kstep, voffB);
        PG8_WAIT_V(6); PG8_BAR;
    } else {
        PG8_STAGE(PG8_SB(0, 0), cB, voffB); PG8_STAGE(PG8_SA(0, 0), cA, voffA); PG8_STAGE(PG8_SB(0, 1), cB + hstep, voffB); PG8_STAGE(PG8_SA(0, 1), cA + hstep, voffA);
        if (wr == 1) PG8_BAR;
        PG8_WAIT_V(4); PG8_BAR;
        PG8_STAGE(PG8_SB(1, 0), cB + kstep, voffB); PG8_STAGE(PG8_SA(1, 0), cA + kstep, voffA); PG8_STAGE(PG8_SB(1, 1), cB + hstep + kstep, voffB);
        PG8_WAIT_V(6); PG8_BAR;
    }
    for (;;) {
        const bool has_next = S.next(ui + 1, nxt);
        const char* nA = has_next ? S.aptr(nxt, tstep) : cA; const char* nB = has_next ? S.bptr(nxt, tstep) : cB;
        for (int t = 0; t < nt; t += 2) {
            const bool last = (t == nt - 2);
            const char* a1 = cA + (size_t)(t + 1) * kstep;
            const char* a2 = last ? nA : cA + (size_t)(t + 2) * kstep; const char* b2 = last ? nB : cB + (size_t)(t + 2) * kstep;
            const char* a3 = a2 + kstep; const char* b3 = b2 + kstep;
            if (last && has_next) S.a_ready(nxt);
            if constexpr (SP2) {
            PG8_LDB(B0, 0, 0); PG8_LDB(B1, 0, 1); PG8_SCHED; PG8_LDA(At, 0, 0); PG8_STAGE(PG8_SA(1, 1), a1 + hstep, voffA);
            PG8_WAIT_V(8); PG8_WAIT_L(0); PG8_BAR; PG8_MMA(0, 0, At, B0); PG8_MMA(0, 1, At, B1); PG8_BAR; PG8_SCHED;
            PG8_LDA(At, 0, 1); PG8_STAGE(PG8_SB(0, 0), b2, voffB); PG8_STAGE(PG8_SB(0, 1), b2 + hstep, voffB); PG8_STAGE(PG8_SA(0, 0), a2, voffA);
            PG8_WAIT_V(8); PG8_WAIT_L(0); PG8_BAR; PG8_MMA(1, 0, At, B0); PG8_MMA(1, 1, At, B1); PG8_BAR; PG8_SCHED;
            PG8_LDB(B0, 1, 0); PG8_LDB(B1, 1, 1); PG8_SCHED; PG8_LDA(At, 1, 0); PG8_STAGE(PG8_SA(0, 1), a2 + hstep, voffA);
            PG8_WAIT_V(8); PG8_WAIT_L(0); PG8_BAR; PG8_MMA(0, 0, At, B0); PG8_MMA(0, 1, At, B1); PG8_BAR; PG8_SCHED;
            PG8_LDA(At, 1, 1); PG8_STAGE(PG8_SB(1, 0), b3, voffB); PG8_STAGE(PG8_SB(1, 1), b3 + hstep, voffB); PG8_STAGE(PG8_SA(1, 0), a3, voffA);
            PG8_WAIT_V(8); PG8_WAIT_L(0); PG8_BAR; PG8_MMA(1, 0, At, B0); PG8_MMA(1, 1, At, B1); PG8_BAR; PG8_SCHED;
            } else {
            PG8_LDB(B0, 0, 0); PG8_SCHED; PG8_LDA(At, 0, 0); PG8_STAGE(PG8_SA(1, 1), a1 + hstep, voffA);
            PG8_WAIT_L(8); PG8_BAR; PG8_WAIT_L(0); PG8_MMA(0, 0, At, B0); PG8_BAR; PG8_SCHED;
            PG8_LDB(B1, 0, 1); PG8_STAGE(PG8_SB(0, 0), b2, voffB);
            PG8_BAR; PG8_WAIT_L(0); PG8_MMA(0, 1, At, B1); PG8_BAR;
            PG8_LDA(At, 0, 1); PG8_STAGE(PG8_SA(0, 0), a2, voffA);
            PG8_BAR; PG8_WAIT_L(0); PG8_MMA(1, 0, At, B0); PG8_BAR; PG8_SCHED;
            PG8_STAGE(PG8_SB(0, 1), b2 + hstep, voffB);
            PG8_WAIT_V(6); PG8_BAR; PG8_MMA(1, 1, At, B1); PG8_BAR;
            PG8_LDB(B0, 1, 0); PG8_SCHED; PG8_LDA(At, 1, 0); PG8_STAGE(PG8_SA(0, 1), a2 + hstep, voffA);
            PG8_WAIT_L(8); PG8_BAR; PG8_WAIT_L(0); PG8_MMA(0, 0, At, B0); PG8_BAR; PG8_SCHED;
            PG8_LDB(B1, 1, 1); PG8_STAGE(PG8_SB(1, 0), b3, voffB);
            PG8_BAR; PG8_WAIT_L(0); PG8_MMA(0, 1, At, B1); PG8_BAR;
            PG8_LDA(At, 1, 1); PG8_STAGE(PG8_SA(1, 0), a3, voffA);
            PG8_BAR; PG8_WAIT_L(0); PG8_MMA(1, 0, At, B0); PG8_BAR; PG8_SCHED;
            PG8_STAGE(PG8_SB(1, 1), b3 + hstep, voffB);
            PG8_WAIT_V(6); PG8_BAR; PG8_MMA(1, 1, At, B1); PG8_BAR;
            }
        }
        if constexpr (ALIGN_EPI) { if (wr == 0) PG8_BAR; }
        if constexpr (!Epi::AFTER_DRAIN) { E(acc, cur, wr, wc, fr, fq); S.done(cur); }
        const bool zero_ = S.zero_after(cur);
        if (!has_next) break;
        if (zero_)
#pragma unroll
        for (int a = 0; a < 2; ++a)
#pragma unroll
            for (int b = 0; b < 2; ++b)
#pragma unroll
                for (int m = 0; m < 4; ++m)
#pragma unroll
                    for (int n = 0; n < 2; ++n) acc[a][b][m][n] = (f32x4){0.f, 0.f, 0.f, 0.f};
        cur = nxt; cA = nA; cB = nB; ++ui; nt = S.nt(cur);
        if constexpr (ALIGN_EPI) { if (wr == 1) PG8_BAR; }
    }
    PG8_WAIT_V(0);
    if constexpr (!ALIGN_EPI) { if (wr == 0) PG8_BAR; }
    PG8_BAR;
    if constexpr (Epi::AFTER_DRAIN) { E.fused(acc, cur, wr, wc, fr, fq, lds, wid, lane); S.done(cur); }
#undef PG8_SA
#undef PG8_SB
#undef PG8_STAGE
#undef PG8_LDA
#undef PG8_LDB
#undef PG8_MMA
#undef PG8_WAIT_V
#undef PG8_WAIT_L
#undef PG8_BAR
#undef PG8_SCHED
}
}
namespace cg = cooperative_groups;
#define LAS __attribute__((address_space(3)))
typedef unsigned short bf16;
typedef short bf16x8 __attribute__((ext_vector_type(8)));
typedef float f32x4 __attribute__((ext_vector_type(4)));
typedef float f32x16 __attribute__((ext_vector_type(16)));
typedef unsigned u32x4 __attribute__((ext_vector_type(4)));
typedef unsigned u32x2 __attribute__((ext_vector_type(2)));

constexpr int DM = 1024, INC = 10240, GT = 16384, NGROUPS = 3, DEPTH = 2;
constexpr int NTHREADS = 512, NWAVES = 8;
constexpr float RMS_EPS = 1e-6f;
constexpr float QSCALE = 0.125f * 1.4426950408889634f;
constexpr size_t MiB = 1u << 20;
constexpr size_t WS_PCNT = 16384;
constexpr size_t WS_SLOTS = 65536;
constexpr size_t WS_KNMAX = 32768;
constexpr size_t WS_WIN = 2 * MiB;
constexpr size_t WS_WAC = 42 * MiB;
constexpr size_t WS_WB = 46 * MiB;
constexpr size_t WS_WO = 50 * MiB;
constexpr size_t WS_R1 = 54 * MiB;
constexpr size_t WS_ZQKV = 86 * MiB;
constexpr size_t WS_ZA = 182 * MiB;
constexpr size_t WS_ZC = 230 * MiB;
constexpr size_t WS_ZBG = 278 * MiB;
constexpr size_t WS_ZM = 310 * MiB;
constexpr size_t WS_AP = 406 * MiB;
constexpr size_t WS_VP = 438 * MiB;
constexpr size_t WS_END = 470 * MiB;
constexpr int RING_BYTES = 131072, LDS_TAB = RING_BYTES, LDS_BYTES = 147456;

struct Params {
    const float* in[20];
    float* out;
    unsigned char* ws;
    double invrev[32];
    int ph_lo, ph_hi;
};

__device__ __forceinline__ float bf2f(unsigned short b) { return __uint_as_float(((unsigned)b) << 16); }
__device__ __forceinline__ float bflo(unsigned w) { return __uint_as_float(w << 16); }
__device__ __forceinline__ float bfhi(unsigned w) { return __uint_as_float(w & 0xffff0000u); }
__device__ __forceinline__ unsigned pk2(float lo, float hi) { return pg8::cvt_pk_bf16(lo, hi); }
__device__ __forceinline__ unsigned short f2bf(float f) { return (unsigned short)(pk2(f, 0.f) & 0xffffu); }
__device__ __forceinline__ float wave_sum(float v) {
#pragma unroll
    for (int o = 1; o < 64; o <<= 1) v += __shfl_xor(v, o);
    return v;
}
__device__ __forceinline__ float sigmoidf_(float x) { return __builtin_amdgcn_rcpf(1.0f + __expf(-x)); }
__device__ __forceinline__ float siluf_(float x) { return x * __builtin_amdgcn_rcpf(1.0f + __expf(-x)); }
__device__ __forceinline__ int crow(int r, int hi) { return (r & 3) + 8 * (r >> 2) + 4 * hi; }

struct EpiZ {
    static constexpr bool PERM = true, AFTER_DRAIN = false;
    bf16 *Qp, *Kp, *Vp, *Za, *Zc, *Zbg, *Zm; const LAS double* tab; int seqlen; unsigned* knmax;
    __device__ __forceinline__ void operator()(const pg8::f32x4 (&acc)[2][2][4][2], const pg8::Unit& u, int wr, int wc, int fr, int fq) const {
        const int pn = u.pn;
        const int row0 = u.pm * 256 + wr * 64 + fr;
        if (pn >= 6 && pn < 14) {
            const int t = pn - 6, isk = t >> 2, vh = 4 * (t & 3) + wc;
            unsigned iv[8];
#pragma unroll
            for (int e = 0; e < 8; ++e) iv[e] = (unsigned)(tab[8 * fq + e] * 4294967296.0);
            const float sc = isk ? 1.0f : QSCALE;
            float kmx = 0.f;
#pragma unroll
            for (int ai = 0; ai < 2; ++ai)
#pragma unroll
                for (int m = 0; m < 4; ++m) {
                    const int tok = row0 + ai * 128 + m * 16;
                    const unsigned pos = (unsigned)(tok & (seqlen - 1));
                    float o1[8], o2[8];
#pragma unroll
                    for (int e = 0; e < 8; ++e) {
                        const float frv = (float)(pos * iv[e]) * 2.3283064365386963e-10f;
                        const float sn = __builtin_amdgcn_sinf(frv), cs = __builtin_amdgcn_cosf(frv);
                        const float x1 = acc[ai][0][m][e >> 2][e & 3], x2 = acc[ai][1][m][e >> 2][e & 3];
                        o1[e] = (x1 * cs - x2 * sn) * sc; o2[e] = (x2 * cs + x1 * sn) * sc;
                    }
                    if (isk) { float n2 = 0.f;
#pragma unroll
                        for (int e = 0; e < 8; ++e) n2 += o1[e] * o1[e] + o2[e] * o2[e];
                        n2 += __shfl_xor(n2, 16); n2 += __shfl_xor(n2, 32);
                        kmx = fmaxf(kmx, n2); }
                    u32x4 w1, w2;
                    w1.x = pk2(o1[0], o1[1]); w1.y = pk2(o1[2], o1[3]); w1.z = pk2(o1[4], o1[5]); w1.w = pk2(o1[6], o1[7]);
                    w2.x = pk2(o2[0], o2[1]); w2.y = pk2(o2[2], o2[3]); w2.z = pk2(o2[4], o2[5]); w2.w = pk2(o2[6], o2[7]);
                    if (!isk) { bf16* qd = Qp + (size_t)tok * 1024 + vh * 64 + 8 * fq; *(u32x4*)qd = w1; *(u32x4*)(qd + 32) = w2; }
                    else { bf16* kd = Kp + (size_t)(vh * 256 + (tok >> 6)) * 4096 + (tok & 63) * 8; *(u32x4*)(kd + fq * 512) = w1; *(u32x4*)(kd + (fq + 4) * 512) = w2; }
                }
            if (isk) { kmx = fmaxf(kmx, __shfl_xor(kmx, 1)); kmx = fmaxf(kmx, __shfl_xor(kmx, 2)); kmx = fmaxf(kmx, __shfl_xor(kmx, 4)); kmx = fmaxf(kmx, __shfl_xor(kmx, 8));
                if (fr == 0 && fq == 0) __hip_atomic_fetch_max(knmax + ((u.pm * 256) / seqlen) * 16 + vh, __float_as_uint(kmx), __ATOMIC_RELAXED, __HIP_MEMORY_SCOPE_AGENT); }
            return;
        }
        if (pn >= 14 && pn < 18) {
            const int t = pn - 14;
            const int hi_ = (fr >> 2) & 1, j_ = (fr & 3) + 4 * (fr >> 3);
#pragma unroll
            for (int ai = 0; ai < 2; ++ai)
#pragma unroll
                for (int m = 0; m < 4; ++m) {
                    const int gt = 4 * u.pm + 2 * ai + wr;
#pragma unroll
                    for (int bj = 0; bj < 2; ++bj) {
                        bf16* vd = Vp + (size_t)((2 * t + bj) * 256 + gt) * 8192 + ((wc * 4 + m) * 2 + hi_) * 256 + (8 * fq) * 8 + j_;
                        const pg8::f32x4 v0 = acc[ai][bj][m][0], v1 = acc[ai][bj][m][1];
                        vd[0] = f2bf(v0[0]); vd[8] = f2bf(v0[1]); vd[16] = f2bf(v0[2]); vd[24] = f2bf(v0[3]);
                        vd[32] = f2bf(v1[0]); vd[40] = f2bf(v1[1]); vd[48] = f2bf(v1[2]); vd[56] = f2bf(v1[3]);
                    }
                }
            return;
        }
        if (pn < 4) {
#pragma unroll
            for (int ai = 0; ai < 2; ++ai)
#pragma unroll
                for (int m = 0; m < 4; ++m) {
                    const pg8::f32x4 u0 = acc[ai][0][m][0], u1 = acc[ai][0][m][1], g0 = acc[ai][1][m][0], g1 = acc[ai][1][m][1];
                    u32x4 w;
                    w.x = pk2(u0[0] * sigmoidf_(g0[0]), u0[1] * sigmoidf_(g0[1])); w.y = pk2(u0[2] * sigmoidf_(g0[2]), u0[3] * sigmoidf_(g0[3]));
                    w.z = pk2(u1[0] * sigmoidf_(g1[0]), u1[1] * sigmoidf_(g1[1])); w.w = pk2(u1[2] * sigmoidf_(g1[2]), u1[3] * sigmoidf_(g1[3]));
                    *(u32x4*)(Za + (size_t)(row0 + ai * 128 + m * 16) * 1024 + pn * 128 + wc * 32 + 8 * fq) = w;
                }
            return;
        }
        if (pn >= 22 && pn < 26) {
#pragma unroll
            for (int ai = 0; ai < 2; ++ai)
#pragma unroll
                for (int m = 0; m < 4; ++m) {
                    const pg8::f32x4 u0 = acc[ai][0][m][0], u1 = acc[ai][0][m][1], g0 = acc[ai][1][m][0], g1 = acc[ai][1][m][1];
                    u32x4 w;
                    w.x = pk2(u0[0] * siluf_(g0[0]), u0[1] * siluf_(g0[1])); w.y = pk2(u0[2] * siluf_(g0[2]), u0[3] * siluf_(g0[3]));
                    w.z = pk2(u1[0] * siluf_(g1[0]), u1[1] * siluf_(g1[1])); w.w = pk2(u1[2] * siluf_(g1[2]), u1[3] * siluf_(g1[3]));
                    *(u32x4*)(Zc + (size_t)(row0 + ai * 128 + m * 16) * 1024 + (pn - 22) * 128 + wc * 32 + 8 * fq) = w;
                }
            return;
        }
        bf16* base; int ld, ct;
        if (pn < 6) { base = Za + 512; ld = 1024; ct = pn - 4; }
        else if (pn < 22) { base = Zbg; ld = 1024; ct = pn - 18; }
        else if (pn < 28) { base = Zc + 512; ld = 1024; ct = pn - 26; }
        else { base = Zm; ld = 3072; ct = pn - 28; }
        const int col0 = ct * 256 + wc * 32 + 8 * fq;
#pragma unroll
        for (int ai = 0; ai < 2; ++ai)
#pragma unroll
            for (int m = 0; m < 4; ++m) {
                bf16* rowp = base + (size_t)(row0 + ai * 128 + m * 16) * ld + col0;
#pragma unroll
                for (int bj = 0; bj < 2; ++bj) {
                    const pg8::f32x4 v0 = acc[ai][bj][m][0], v1 = acc[ai][bj][m][1];
                    u32x4 w; w.x = pk2(v0[0], v0[1]); w.y = pk2(v0[2], v0[3]); w.z = pk2(v1[0], v1[1]); w.w = pk2(v1[2], v1[3]);
                    *(u32x4*)(rowp + bj * 128) = w;
                }
            }
    }
};
__device__ __forceinline__ int wperm_qk(int n) {
    if (n < 1024) { const int half = n >> 9, c = n & 511; return 256 * (c >> 7) + 128 * half + (c & 127); }
    if (n >= 5632 && n < 7168) {
        if (n < 6144) { const int c = n - 5632; return 5632 + 256 * (c >> 7) + (c & 127); }
        if (n >= 6656) { const int c = n - 6656; return 5632 + 256 * (c >> 7) + 128 + (c & 127); }
        return 6656 + (n - 6144);
    }
    if (n < 1536 || n >= 3584) return n;
    const int o = (n - 1536) & 255, t = (n - 1536) >> 8, hm = o >> 6, half = (o >> 5) & 1, dd = o & 31;
    return 1536 + 256 * t + 128 * half + 32 * hm + dd;
}
__device__ __forceinline__ float eneg_(float x) { return fminf(__expf(-x), 1e30f); }
struct SegOrder {
    pg8::StaticOrder so; const bf16 *AC, *B, *WAC, *WB;
    __device__ bool next(int i, pg8::Unit& u) const { const bool ok = so.next(i / 3, u); u.seg = i % 3; return ok; }
    __device__ __forceinline__ const char* aptr(const pg8::Unit& u, size_t tstep) const { return (const char*)(u.seg == 1 ? B : AC) + (size_t)u.pm * tstep + (u.seg == 2 ? 1024 : 0); }
    __device__ __forceinline__ const char* bptr(const pg8::Unit& u, size_t tstep) const { return (const char*)(u.seg == 1 ? WB : WAC) + (size_t)u.pn * tstep + (u.seg == 2 ? 1024 : 0); }
    __device__ __forceinline__ int nt(const pg8::Unit& u) const { return u.seg == 1 ? 16 : 8; }
    __device__ __forceinline__ bool zero_after(const pg8::Unit& u) const { return u.seg == 2; }
    __device__ __forceinline__ void a_ready(const pg8::Unit&) const {}
    __device__ __forceinline__ void done(const pg8::Unit&) const {}
};
struct EpiGate3 {
    static constexpr bool PERM = true, AFTER_DRAIN = false;
    const bf16* Zm; bf16* Yb;
    __device__ __forceinline__ void operator()(pg8::f32x4 (&acc)[2][2][4][2], const pg8::Unit& u, int wr, int wc, int fr, int fq) const {
        const int row0 = u.pm * 256 + wr * 64 + fr, col0 = u.pn * 256 + wc * 32 + 8 * fq;
        const int seg = u.seg;
        const int jn = seg, jd = seg == 2 ? 2 : seg + 1;
#pragma unroll
        for (int ai = 0; ai < 2; ++ai)
#pragma unroll
            for (int m = 0; m < 4; ++m) {
                const size_t row = (size_t)(row0 + ai * 128 + m * 16);
#pragma unroll
                for (int bj = 0; bj < 2; ++bj) {
                    const int col = col0 + bj * 128;
                    const u32x4 g1 = *(const u32x4*)(Zm + row * 3072 + jn * 1024 + col);
                    const u32x4 g2 = *(const u32x4*)(Zm + row * 3072 + jd * 1024 + col);
                    float e1[8], e2[8];
                    e1[0] = eneg_(bflo(g1.x)); e1[1] = eneg_(bfhi(g1.x)); e1[2] = eneg_(bflo(g1.y)); e1[3] = eneg_(bfhi(g1.y));
                    e1[4] = eneg_(bflo(g1.z)); e1[5] = eneg_(bfhi(g1.z)); e1[6] = eneg_(bflo(g1.w)); e1[7] = eneg_(bfhi(g1.w));
                    e2[0] = eneg_(bflo(g2.x)); e2[1] = eneg_(bfhi(g2.x)); e2[2] = eneg_(bflo(g2.y)); e2[3] = eneg_(bfhi(g2.y));
                    e2[4] = eneg_(bflo(g2.z)); e2[5] = eneg_(bfhi(g2.z)); e2[6] = eneg_(bflo(g2.w)); e2[7] = eneg_(bfhi(g2.w));
                    float f[8];
#pragma unroll
                    for (int i = 0; i < 8; ++i) f[i] = (seg == 2 ? 1.0f : 1.0f + e2[i]) * __builtin_amdgcn_rcpf(1.0f + e1[i]);
                    pg8::f32x4& a0 = acc[ai][bj][m][0]; pg8::f32x4& a1 = acc[ai][bj][m][1];
                    a0[0] *= f[0]; a0[1] *= f[1]; a0[2] *= f[2]; a0[3] *= f[3]; a1[0] *= f[4]; a1[1] *= f[5]; a1[2] *= f[6]; a1[3] *= f[7];
                    if (seg == 2) { u32x4 w; w.x = pk2(a0[0], a0[1]); w.y = pk2(a0[2], a0[3]); w.z = pk2(a1[0], a1[1]); w.w = pk2(a1[2], a1[3]);
                                    *(u32x4*)(Yb + row * 1024 + col) = w; }
                }
                asm volatile("" ::: "memory");
            }
    }
};
struct EpiRes {
    static constexpr bool PERM = true, AFTER_DRAIN = false;
    const float* res; float* out;
    __device__ __forceinline__ void operator()(const pg8::f32x4 (&acc)[2][2][4][2], const pg8::Unit& u, int wr, int wc, int fr, int fq) const {
        const int row0 = u.pm * 256 + wr * 64 + fr, col0 = u.pn * 256 + wc * 32 + 8 * fq;
#pragma unroll
        for (int ai = 0; ai < 2; ++ai)
#pragma unroll
            for (int m = 0; m < 4; ++m) {
                const size_t row = (size_t)(row0 + ai * 128 + m * 16);
#pragma unroll
                for (int bj = 0; bj < 2; ++bj) {
                    const size_t off = row * 1024 + col0 + bj * 128;
                    const f32x4 r0 = *(const f32x4*)(res + off), r1 = *(const f32x4*)(res + off + 4);
                    const pg8::f32x4 a0 = acc[ai][bj][m][0], a1 = acc[ai][bj][m][1];
                    f32x4 o0, o1;
                    o0[0] = r0[0] + a0[0]; o0[1] = r0[1] + a0[1]; o0[2] = r0[2] + a0[2]; o0[3] = r0[3] + a0[3];
                    o1[0] = r1[0] + a1[0]; o1[1] = r1[1] + a1[1]; o1[2] = r1[2] + a1[2]; o1[3] = r1[3] + a1[3];
                    *(f32x4*)(out + off) = o0; *(f32x4*)(out + off + 4) = o1;
                }
            }
    }
};

struct EpiResNorm {
    static constexpr bool PERM = true, AFTER_DRAIN = true;
    const float* res; float* out; bf16* xn; const float* g; unsigned* slots; unsigned* cnt;
    __device__ __forceinline__ void fused(pg8::f32x4 (&acc)[2][2][4][2], const pg8::Unit& u, int wr, int wc, int fr, int fq, PG8_LAS unsigned char* lds, int wid, int lane) const {
        LAS float* P = (LAS float*)lds;
        LAS float* S = (LAS float*)(lds + 4096);
        const int rl0 = wr * 64 + fr, col0 = u.pn * 256 + wc * 32 + 8 * fq;
#pragma unroll
        for (int ai = 0; ai < 2; ++ai)
#pragma unroll
            for (int m = 0; m < 4; ++m) {
                const int rl = rl0 + ai * 128 + m * 16; const size_t row = (size_t)(u.pm * 256 + rl);
                float s = 0.f;
#pragma unroll
                for (int bj = 0; bj < 2; ++bj) {
                    const size_t off = row * 1024 + col0 + bj * 128;
                    const f32x4 r0 = *(const f32x4*)(res + off), r1 = *(const f32x4*)(res + off + 4);
                    pg8::f32x4& a0 = acc[ai][bj][m][0]; pg8::f32x4& a1 = acc[ai][bj][m][1];
                    a0[0] += r0[0]; a0[1] += r0[1]; a0[2] += r0[2]; a0[3] += r0[3]; a1[0] += r1[0]; a1[1] += r1[1]; a1[2] += r1[2]; a1[3] += r1[3];
                    s += ((a0[0] * a0[0] + a0[1] * a0[1]) + (a0[2] * a0[2] + a0[3] * a0[3])) + ((a1[0] * a1[0] + a1[1] * a1[1]) + (a1[2] * a1[2] + a1[3] * a1[3]));
                }
                s += __shfl_xor(s, 16); s += __shfl_xor(s, 32);
                if (fq == 0) P[rl * 4 + wc] = s;
                if (m & 1) asm volatile("" ::: "memory");
            }
        asm volatile("s_waitcnt lgkmcnt(0)" ::: "memory"); __builtin_amdgcn_s_barrier(); asm volatile("" ::: "memory");
        if (wid < 4) {
            const int rl = wid * 64 + lane;
            const float t = (P[rl * 4 + 0] + P[rl * 4 + 1]) + (P[rl * 4 + 2] + P[rl * 4 + 3]);
            __hip_atomic_store(slots + ((size_t)(u.pm * 256 + rl) * 4 + u.pn), __float_as_uint(t), __ATOMIC_RELAXED, __HIP_MEMORY_SCOPE_AGENT);
            asm volatile("s_waitcnt vmcnt(0)" ::: "memory");
            if (lane == 0) __hip_atomic_fetch_add(cnt + u.pm, 1u, __ATOMIC_RELAXED, __HIP_MEMORY_SCOPE_AGENT);
        }
        if (wid == 0) {
            unsigned sp = 0;
            while ((unsigned)__builtin_amdgcn_readfirstlane(__hip_atomic_load(cnt + u.pm, __ATOMIC_RELAXED, __HIP_MEMORY_SCOPE_AGENT)) < 16u) { __builtin_amdgcn_s_sleep(2); if (++sp > (1u << 22)) break; }
            __builtin_amdgcn_fence(__ATOMIC_ACQUIRE, "agent");
        }
        asm volatile("s_waitcnt vmcnt(0) lgkmcnt(0)" ::: "memory"); __builtin_amdgcn_s_barrier(); asm volatile("" ::: "memory");
        if (wid < 4) {
            const int rl = wid * 64 + lane; const unsigned* sl = slots + (size_t)(u.pm * 256 + rl) * 4;
            const float t = (__uint_as_float(__hip_atomic_load(sl + 0, __ATOMIC_RELAXED, __HIP_MEMORY_SCOPE_AGENT)) + __uint_as_float(__hip_atomic_load(sl + 1, __ATOMIC_RELAXED, __HIP_MEMORY_SCOPE_AGENT)))
                          + (__uint_as_float(__hip_atomic_load(sl + 2, __ATOMIC_RELAXED, __HIP_MEMORY_SCOPE_AGENT)) + __uint_as_float(__hip_atomic_load(sl + 3, __ATOMIC_RELAXED, __HIP_MEMORY_SCOPE_AGENT)));
            S[rl] = rsqrtf(t * (1.0f / DM) + RMS_EPS);
        }
        asm volatile("s_waitcnt lgkmcnt(0)" ::: "memory"); __builtin_amdgcn_s_barrier(); asm volatile("" ::: "memory");
        f32x4 gg[2][2];
#pragma unroll
        for (int bj = 0; bj < 2; ++bj) { gg[bj][0] = *(const f32x4*)(g + col0 + bj * 128); gg[bj][1] = *(const f32x4*)(g + col0 + bj * 128 + 4); }
#pragma unroll
        for (int ai = 0; ai < 2; ++ai)
#pragma unroll
            for (int m = 0; m < 4; ++m) {
                const int rl = rl0 + ai * 128 + m * 16; const size_t row = (size_t)(u.pm * 256 + rl);
                const float rs = S[rl];
#pragma unroll
                for (int bj = 0; bj < 2; ++bj) {
                    const size_t off = row * 1024 + col0 + bj * 128;
                    const pg8::f32x4 a0 = acc[ai][bj][m][0], a1 = acc[ai][bj][m][1];
                    f32x4 n0, n1;
                    n0[0] = a0[0] * rs * gg[bj][0][0]; n0[1] = a0[1] * rs * gg[bj][0][1]; n0[2] = a0[2] * rs * gg[bj][0][2]; n0[3] = a0[3] * rs * gg[bj][0][3];
                    n1[0] = a1[0] * rs * gg[bj][1][0]; n1[1] = a1[1] * rs * gg[bj][1][1]; n1[2] = a1[2] * rs * gg[bj][1][2]; n1[3] = a1[3] * rs * gg[bj][1][3];
                    if (xn) { f32x4 x0, x1; x0[0] = a0[0]; x0[1] = a0[1]; x0[2] = a0[2]; x0[3] = a0[3]; x1[0] = a1[0]; x1[1] = a1[1]; x1[2] = a1[2]; x1[3] = a1[3];
                        *(f32x4*)(out + off) = x0; *(f32x4*)(out + off + 4) = x1;
                        u32x4 w; w.x = pk2(n0[0], n0[1]); w.y = pk2(n0[2], n0[3]); w.z = pk2(n1[0], n1[1]); w.w = pk2(n1[2], n1[3]); *(u32x4*)(xn + off) = w; }
                    else { *(f32x4*)(out + off) = n0; *(f32x4*)(out + off + 4) = n1; }
                }
                if (m & 1) asm volatile("" ::: "memory");
            }
    }
};
struct Ctx {
    LAS unsigned char* lds;
    int tid, lane, wave, G, b;
};

template <bool QKPERM = false> __device__ __forceinline__ void transpose_item(const float* W, int K, int N, bf16* WT, LAS float* scr, int item, int lane, int ld) {
    const int nblk = N / 32, kb = item / nblk, nb = item % nblk, k0 = 64 * kb, n0 = 32 * nb;
#pragma unroll 8
    for (int i = 0; i < 32; ++i) { const int kk = 2 * i + (lane >> 5); scr[kk * 33 + (lane & 31)] = W[(size_t)(k0 + kk) * N + n0 + (lane & 31)]; }
    asm volatile("s_waitcnt lgkmcnt(0)" ::: "memory");
    const int c = lane & 7;
#pragma unroll
    for (int j = 0; j < 4; ++j) { const int n = (lane >> 3) + 8 * j; const LAS float* s = scr + (8 * c) * 33 + n;
        u32x4 o; o.x = pk2(s[0 * 33], s[1 * 33]); o.y = pk2(s[2 * 33], s[3 * 33]); o.z = pk2(s[4 * 33], s[5 * 33]); o.w = pk2(s[6 * 33], s[7 * 33]);
        *(u32x4*)(WT + (size_t)(QKPERM ? wperm_qk(n0 + n) : (n0 + n)) * ld + k0 + 8 * c) = o; }
    asm volatile("s_waitcnt lgkmcnt(0)" ::: "memory");
}
__device__ __forceinline__ void phase_weights(const Ctx& C, const Params& p) {
    LAS float* scr = (LAS float*)(C.lds + C.wave * 16384);
    const int gw = C.b * NWAVES + C.wave, NGW = C.G * NWAVES;
    constexpr int I_IN = 16 * 320, I_A = 8 * 32, I_B = 16 * 32, I_C = 8 * 32, I_O = 16 * 32, I_L = I_IN + I_A + I_B + I_C + I_O;
    for (int it = gw; it < DEPTH * I_L; it += NGW) {
        const int l = it / I_L; int r = it % I_L;
        if (r < I_IN) { transpose_item<true>(p.in[3] + (size_t)l * 1024 * INC, 1024, INC, (bf16*)(p.ws + WS_WIN) + (size_t)l * INC * 1024, scr, r, C.lane, 1024); continue; } r -= I_IN;
        if (r < I_A) { transpose_item(p.in[7] + (size_t)l * 512 * 1024, 512, 1024, (bf16*)(p.ws + WS_WAC) + (size_t)l * 1024 * 1024, scr, r, C.lane, 1024); continue; } r -= I_A;
        if (r < I_B) { transpose_item(p.in[13] + (size_t)l * 1024 * 1024, 1024, 1024, (bf16*)(p.ws + WS_WB) + (size_t)l * 1024 * 1024, scr, r, C.lane, 1024); continue; } r -= I_B;
        if (r < I_C) { transpose_item(p.in[17] + (size_t)l * 512 * 1024, 512, 1024, (bf16*)(p.ws + WS_WAC) + (size_t)l * 1024 * 1024 + 512, scr, r, C.lane, 1024); continue; } r -= I_C;
        transpose_item(p.in[18] + (size_t)l * 1024 * 1024, 1024, 1024, (bf16*)(p.ws + WS_WO) + (size_t)l * 1024 * 1024, scr, r, C.lane, 1024);
    }
}

__device__ __forceinline__ void phase_norm_in(const Ctx& C, const float* x, const float* g, bf16* XN, unsigned* knmax) {
    const int gw = C.b * NWAVES + C.wave, NGW = C.G * NWAVES;
    if (C.b == 0 && C.tid < 128) knmax[C.tid] = 0u;
    f32x4 gg[4];
#pragma unroll
    for (int j = 0; j < 4; ++j) gg[j] = ((const f32x4*)g)[C.lane + 64 * j];
#pragma unroll 2
    for (int m = gw; m < GT; m += NGW) {
        const f32x4* xr = (const f32x4*)(x + (size_t)m * DM) + C.lane;
        f32x4 v[4]; float ss = 0.f;
#pragma unroll
        for (int j = 0; j < 4; ++j) { v[j] = xr[64 * j]; ss += (v[j][0] * v[j][0] + v[j][1] * v[j][1]) + (v[j][2] * v[j][2] + v[j][3] * v[j][3]); }
        const float rstd = rsqrtf(wave_sum(ss) * (1.0f / DM) + RMS_EPS);
        u32x2* o8 = (u32x2*)(XN + (size_t)m * DM) + C.lane;
#pragma unroll
        for (int j = 0; j < 4; ++j) { u32x2 w; w.x = pk2(v[j][0] * rstd * gg[j][0], v[j][1] * rstd * gg[j][1]); w.y = pk2(v[j][2] * rstd * gg[j][2], v[j][3] * rstd * gg[j][3]); o8[64 * j] = w; }
    }
}
__device__ __forceinline__ void phase_norm_final(const Ctx& C, float* x, const float* g) {
    const int gw = C.b * NWAVES + C.wave, NGW = C.G * NWAVES;
    f32x4 gg[4];
#pragma unroll
    for (int j = 0; j < 4; ++j) gg[j] = ((const f32x4*)g)[C.lane + 64 * j];
#pragma unroll 2
    for (int m = gw; m < GT; m += NGW) {
        f32x4* xr = (f32x4*)(x + (size_t)m * DM) + C.lane;
        f32x4 v[4]; float ss = 0.f;
#pragma unroll
        for (int j = 0; j < 4; ++j) { v[j] = xr[64 * j]; ss += (v[j][0] * v[j][0] + v[j][1] * v[j][1]) + (v[j][2] * v[j][2] + v[j][3] * v[j][3]); }
        const float rstd = rsqrtf(wave_sum(ss) * (1.0f / DM) + RMS_EPS);
#pragma unroll
        for (int j = 0; j < 4; ++j) { f32x4 o; o[0] = v[j][0] * rstd * gg[j][0]; o[1] = v[j][1] * rstd * gg[j][1]; o[2] = v[j][2] * rstd * gg[j][2]; o[3] = v[j][3] * rstd * gg[j][3]; xr[64 * j] = o; }
    }
}

__device__ __forceinline__ void phase_qkv_prep(const Ctx& C, bf16* Zqkv, bf16* Kp, bf16* Vp, int seqlen) {
    const LAS double* tab = (const LAS double*)(C.lds + LDS_TAB);
    for (int gt = C.b; gt < GT / 64; gt += C.G) {
        const int pos0 = (gt * 64) % seqlen;
#pragma unroll 2
        for (int it = 0; it < 16; ++it) {
            const int e = C.tid + NTHREADS * it;
            const int c8 = e & 3, vh = (e >> 2) & 15, qk = (e >> 6) & 1, tok = e >> 7;
            bf16* src = Zqkv + (size_t)(gt * 64 + tok) * 3072 + qk * 1024 + vh * 64;
            const u32x4 x1 = *(const u32x4*)(src + 8 * c8), x2 = *(const u32x4*)(src + 32 + 8 * c8);
            const double pos = (double)(pos0 + tok);
            float a1[8], a2[8];
            a1[0] = bflo(x1.x); a1[1] = bfhi(x1.x); a1[2] = bflo(x1.y); a1[3] = bfhi(x1.y); a1[4] = bflo(x1.z); a1[5] = bfhi(x1.z); a1[6] = bflo(x1.w); a1[7] = bfhi(x1.w);
            a2[0] = bflo(x2.x); a2[1] = bfhi(x2.x); a2[2] = bflo(x2.y); a2[3] = bfhi(x2.y); a2[4] = bflo(x2.z); a2[5] = bfhi(x2.z); a2[6] = bflo(x2.w); a2[7] = bfhi(x2.w);
            const float sc = qk == 0 ? QSCALE : 1.0f;
            float o1[8], o2[8];
#pragma unroll
            for (int jj = 0; jj < 8; ++jj) {
                double rev = pos * tab[8 * c8 + jj]; rev -= floor(rev);
                const float fr = (float)rev;
                const float sn = __builtin_amdgcn_sinf(fr), cs = __builtin_amdgcn_cosf(fr);
                o1[jj] = (a1[jj] * cs - a2[jj] * sn) * sc; o2[jj] = (a2[jj] * cs + a1[jj] * sn) * sc;
            }
            u32x4 w1, w2;
            w1.x = pk2(o1[0], o1[1]); w1.y = pk2(o1[2], o1[3]); w1.z = pk2(o1[4], o1[5]); w1.w = pk2(o1[6], o1[7]);
            w2.x = pk2(o2[0], o2[1]); w2.y = pk2(o2[2], o2[3]); w2.z = pk2(o2[4], o2[5]); w2.w = pk2(o2[6], o2[7]);
            if (qk == 0) { *(u32x4*)(src + 8 * c8) = w1; *(u32x4*)(src + 32 + 8 * c8) = w2; }
            else { bf16* kb = Kp + (size_t)(vh * 256 + gt) * 4096 + tok * 8;
                   *(u32x4*)(kb + c8 * 512) = w1; *(u32x4*)(kb + (c8 + 4) * 512) = w2; }
        }
#pragma unroll 4
        for (int it = 0; it < 16; ++it) {
            const int e = C.tid + NTHREADS * it;
            const int n = e & 31, hi = (e >> 5) & 1, ks = (e >> 6) & 3, db = (e >> 8) & 3, h = (e >> 10) & 7;
            const bf16* src = Zqkv + (size_t)(gt * 64 + 16 * ks + 4 * hi) * 3072 + 2048 + h * 128 + 32 * db + n;
            unsigned short v[8];
#pragma unroll
            for (int j = 0; j < 8; ++j) v[j] = src[(size_t)((j & 3) + 8 * (j >> 2)) * 3072];
            u32x4 w; w.x = v[0] | ((unsigned)v[1] << 16); w.y = v[2] | ((unsigned)v[3] << 16); w.z = v[4] | ((unsigned)v[5] << 16); w.w = v[6] | ((unsigned)v[7] << 16);
            *(u32x4*)(Vp + (size_t)(h * 256 + gt) * 8192 + ((db * 4 + ks) * 2 + hi) * 256 + n * 8) = w;
        }
    }
}

__device__ __forceinline__ void phase_conv(const Ctx& C, const bf16* Za, bf16* Ap, const float* cw, const float* cb, const float* cng, int seqlen) {
    LAS float* A = (LAS float*)C.lds;
    const int c = C.tid;
    float w[31];
#pragma unroll
    for (int k = 0; k < 31; ++k) w[k] = cw[k * 512 + c];
    const float bias = cb[c];
    const f32x4 gn0 = *(const f32x4*)(cng + C.lane * 8), gn1 = *(const f32x4*)(cng + C.lane * 8 + 4);
    for (int tt = C.b; tt < GT / 32; tt += C.G) {
        const int t0 = tt * 32, ss = (t0 / seqlen) * seqlen, se = ss + seqlen;
        u32x4 xu[8];
#pragma unroll
        for (int ii = 0; ii < 8; ++ii) { const int i = C.wave + 8 * ii, tok = t0 - 15 + i;
            xu[ii] = u32x4{0u, 0u, 0u, 0u};
            if (i < 62 && tok >= ss && tok < se) xu[ii] = *(const u32x4*)(Za + (size_t)tok * 1024 + C.lane * 8); }
#pragma unroll
        for (int ii = 0; ii < 8; ++ii) { const int i = C.wave + 8 * ii;
            if (i < 62) { f32x4 a0, a1;
                a0[0] = bflo(xu[ii].x); a0[1] = bfhi(xu[ii].x); a0[2] = bflo(xu[ii].y); a0[3] = bfhi(xu[ii].y);
                a1[0] = bflo(xu[ii].z); a1[1] = bfhi(xu[ii].z); a1[2] = bflo(xu[ii].w); a1[3] = bfhi(xu[ii].w);
                *(LAS f32x4*)(A + i * 512 + C.lane * 8) = a0; *(LAS f32x4*)(A + i * 512 + C.lane * 8 + 4) = a1; } }
        u32x4 gt4[4];
#pragma unroll
        for (int tq = 0; tq < 4; ++tq) gt4[tq] = *(const u32x4*)(Za + (size_t)(t0 + C.wave * 4 + tq) * 1024 + 512 + C.lane * 8);
        __syncthreads();
#pragma unroll 1
        for (int t = 0; t < 32; t += 4) {
            float a0 = bias, a1 = bias, a2 = bias, a3 = bias;
#pragma unroll
            for (int k = 0; k < 34; ++k) {
                const float x = A[(t + k) * 512 + c];
                if (k < 31) a0 += w[k] * x;
                if (k >= 1 && k < 32) a1 += w[k - 1] * x;
                if (k >= 2 && k < 33) a2 += w[k - 2] * x;
                if (k >= 3) a3 += w[k - 3] * x;
            }
            A[t * 512 + c] = a0; A[(t + 1) * 512 + c] = a1; A[(t + 2) * 512 + c] = a2; A[(t + 3) * 512 + c] = a3;
        }
        __syncthreads();
#pragma unroll
        for (int tq = 0; tq < 4; ++tq) {
            const int t = C.wave * 4 + tq, tok = t0 + t;
            const f32x4 y0 = *(const LAS f32x4*)(A + t * 512 + C.lane * 8), y1 = *(const LAS f32x4*)(A + t * 512 + C.lane * 8 + 4);
            float sq = (y0[0] * y0[0] + y0[1] * y0[1]) + (y0[2] * y0[2] + y0[3] * y0[3]) + (y1[0] * y1[0] + y1[1] * y1[1]) + (y1[2] * y1[2] + y1[3] * y1[3]);
            const float rstd = rsqrtf(wave_sum(sq) * (1.0f / 512) + RMS_EPS);
            const u32x4 g = gt4[tq];
            u32x4 o;
            o.x = pk2(siluf_(y0[0] * rstd * gn0[0]) * siluf_(bflo(g.x)), siluf_(y0[1] * rstd * gn0[1]) * siluf_(bfhi(g.x)));
            o.y = pk2(siluf_(y0[2] * rstd * gn0[2]) * siluf_(bflo(g.y)), siluf_(y0[3] * rstd * gn0[3]) * siluf_(bfhi(g.y)));
            o.z = pk2(siluf_(y1[0] * rstd * gn1[0]) * siluf_(bflo(g.z)), siluf_(y1[1] * rstd * gn1[1]) * siluf_(bfhi(g.z)));
            o.w = pk2(siluf_(y1[2] * rstd * gn1[2]) * siluf_(bflo(g.w)), siluf_(y1[3] * rstd * gn1[3]) * siluf_(bfhi(g.w)));
            *(u32x4*)(Ap + (size_t)tok * 1024 + C.lane * 8) = o;
        }
        __syncthreads();
    }
}

__device__ __forceinline__ void phase_sgu(const Ctx& C, const bf16* Zc, bf16* Cp, const float* sng, const float* sw, const float* sb) {
    constexpr int QS = 136;
    LAS bf16* cvT = (LAS bf16*)C.lds;
    LAS float* rs = (LAS float*)(C.lds + 256 * QS * 2);
    const int r32 = C.lane & 31, hi = C.lane >> 5;
    for (int item = C.b; item < 2 * (GT / 128); item += C.G) {
        const int ch = item >> 1, gp = item & 1;
        const int tokbase = ch * 128;
        {
            u32x4 x[16];
#pragma unroll
            for (int qq = 0; qq < 16; ++qq) x[qq] = *(const u32x4*)(Zc + (size_t)(tokbase + C.wave * 16 + qq) * 1024 + 512 + C.lane * 8);
#pragma unroll
            for (int qq = 0; qq < 16; ++qq) {
                float s = bflo(x[qq].x) * bflo(x[qq].x) + bfhi(x[qq].x) * bfhi(x[qq].x) + bflo(x[qq].y) * bflo(x[qq].y) + bfhi(x[qq].y) * bfhi(x[qq].y)
                        + bflo(x[qq].z) * bflo(x[qq].z) + bfhi(x[qq].z) * bfhi(x[qq].z) + bflo(x[qq].w) * bflo(x[qq].w) + bfhi(x[qq].w) * bfhi(x[qq].w);
                s = wave_sum(s);
                if (C.lane == 0) rs[C.wave * 16 + qq] = rsqrtf(s * (1.0f / 512) + RMS_EPS);
            }
        }
        __syncthreads();
        const int gl = C.wave >> 2, pt = C.wave & 3, g = 2 * gp + gl;
        bf16x8 af[8];
        {   const float* wrow = sw + ((size_t)g * 128 + 32 * pt + r32) * 128 + 8 * hi;
#pragma unroll
            for (int ks = 0; ks < 8; ++ks) { const f32x4 w0 = *(const f32x4*)(wrow + 16 * ks), w1 = *(const f32x4*)(wrow + 16 * ks + 4);
                u32x4 pk; pk.x = pk2(w0[0], w0[1]); pk.y = pk2(w0[2], w0[3]); pk.z = pk2(w1[0], w1[1]); pk.w = pk2(w1[2], w1[3]);
                af[ks] = __builtin_bit_cast(bf16x8, pk); } }
        float bb[16];
#pragma unroll
        for (int r = 0; r < 16; ++r) bb[r] = sb[g * 128 + 32 * pt + crow(r, hi)];
        {
            u32x4 x[8];
#pragma unroll
            for (int it = 0; it < 8; ++it) { const int e = C.tid + NTHREADS * it, q = e & 127, chunk = e >> 7;
                x[it] = *(const u32x4*)(Zc + (size_t)(tokbase + q) * 1024 + 512 + 256 * gp + 8 * chunk); }
#pragma unroll
            for (int it = 0; it < 8; ++it) {
                const int e = C.tid + NTHREADS * it, q = e & 127, chunk = e >> 7;
                const int ch0 = 256 * gp + 8 * chunk;
                const float r = rs[q];
                const f32x4 g0 = *(const f32x4*)(sng + ch0), g1 = *(const f32x4*)(sng + ch0 + 4);
                LAS bf16* dst = cvT + (8 * chunk) * QS + q;
                dst[0 * QS] = f2bf(bflo(x[it].x) * r * g0[0]); dst[1 * QS] = f2bf(bfhi(x[it].x) * r * g0[1]);
                dst[2 * QS] = f2bf(bflo(x[it].y) * r * g0[2]); dst[3 * QS] = f2bf(bfhi(x[it].y) * r * g0[3]);
                dst[4 * QS] = f2bf(bflo(x[it].z) * r * g1[0]); dst[5 * QS] = f2bf(bfhi(x[it].z) * r * g1[1]);
                dst[6 * QS] = f2bf(bflo(x[it].w) * r * g1[2]); dst[7 * QS] = f2bf(bfhi(x[it].w) * r * g1[3]);
            }
        }
        __syncthreads();
#pragma unroll 2
        for (int dt = 0; dt < 4; ++dt) {
            const int col = g * 128 + 32 * dt + r32;
            unsigned short uu[16];
#pragma unroll
            for (int r = 0; r < 16; ++r) { const size_t tok = (size_t)(tokbase + 32 * pt + crow(r, hi)); uu[r] = Zc[tok * 1024 + col]; }
            f32x16 acc = {};
            const LAS bf16* brow = cvT + (gl * 128 + 32 * dt + r32) * QS + 8 * hi;
#pragma unroll
            for (int ks = 0; ks < 8; ++ks) { const bf16x8 bfr = *(const LAS bf16x8*)(brow + 16 * ks);
                acc = __builtin_amdgcn_mfma_f32_32x32x16_bf16(af[ks], bfr, acc, 0, 0, 0); }
#pragma unroll
            for (int r = 0; r < 16; ++r) { const size_t tok = (size_t)(tokbase + 32 * pt + crow(r, hi));
                Cp[tok * 1024 + 512 + col] = f2bf(bf2f(uu[r]) * (acc[r] + bb[r])); }
        }
        __syncthreads();
    }
}
#ifndef ATT_THR
#define ATT_THR 30.0f
#endif
__device__ __forceinline__ float swapmax(float m) {
    auto rr = __builtin_amdgcn_permlane32_swap(__float_as_uint(m), __float_as_uint(m), false, false);
    float r; asm("v_max_f32_e32 %0, %1, %2" : "=v"(r) : "v"(__uint_as_float(rr[0])), "v"(__uint_as_float(rr[1]))); return r;
}
__device__ __forceinline__ float swapsum(float m) {
    auto rr = __builtin_amdgcn_permlane32_swap(__float_as_uint(m), __float_as_uint(m), false, false);
    return __uint_as_float(rr[0]) + __uint_as_float(rr[1]);
}
#define SBAR() __builtin_amdgcn_sched_barrier(0)
__device__ __forceinline__ void glds16(const void* gsrc, unsigned lds_dst) { unsigned keep;
    asm volatile("s_mov_b32 %0, m0\n\ts_mov_b32 m0, %2\n\ts_nop 0\n\tglobal_load_lds_dwordx4 %1, off\n\ts_mov_b32 m0, %0" : "=&s"(keep) : "v"(gsrc), "s"(lds_dst) : "memory"); }
#define ATT_WAIT_BAR(N) asm volatile("s_waitcnt vmcnt(" #N ") lgkmcnt(0)\n\ts_barrier" ::: "memory")
constexpr int ATT_KB = 0, ATT_VB = 3 * 16384, ATT_WS = RING_BYTES + 512;
static_assert(ATT_WS + 8 * 256 <= LDS_BYTES, "attention scratch inside LDS");
#define MFMA32(A, B, Cc) __builtin_amdgcn_mfma_f32_32x32x16_bf16(A, B, Cc, 0, 0, 0)
#define EX2(x) __builtin_amdgcn_exp2f(x)
__device__ __forceinline__ bf16x8 pack8(const f32x16& p, int b) {
    u32x4 w; w.x = pk2(p[b], p[b + 1]); w.y = pk2(p[b + 2], p[b + 3]); w.z = pk2(p[b + 4], p[b + 5]); w.w = pk2(p[b + 6], p[b + 7]);
    return __builtin_bit_cast(bf16x8, w);
}
__device__ __forceinline__ float max3f(float a, float b, float c) { float r; asm("v_max3_f32 %0, %1, %2, %3" : "=v"(r) : "v"(a), "v"(b), "v"(c)); return r; }
__device__ __forceinline__ float fadd_s(float a, float b) { float r; asm("v_add_f32_e32 %0, %1, %2" : "=v"(r) : "v"(a), "v"(b)); return r; }
#define SUM4(P, B) fadd_s(fadd_s(P[B], P[(B) + 1]), fadd_s(P[(B) + 2], P[(B) + 3]))
__device__ __forceinline__ float max2f(float a, float b) { float r; asm("v_max_f32_e32 %0, %1, %2" : "=v"(r) : "v"(a), "v"(b)); return r; }
#define ATT_STEP(P0, P1, N0, N1, TT) do { \
    const int t_ = (TT); \
      \
      \
    const int tk_ = (t_ + 3 < T) ? t_ + 3 : T - 1, tv_ = (t_ + 2 < T) ? t_ + 2 : T - 1; \
    const bf16* kn_ = Kt + (size_t)tk_ * 4096 + C.tid * 8; const bf16* vn_ = Vt + (size_t)tv_ * 8192 + C.tid * 8; \
    const LAS unsigned char* kb = lds + ATT_KB + s1 * 16384 + mapc * 8192 + hi * 1024 + r32 * 16; \
    const LAS unsigned char* vb = lds + ATT_VB + s0 * 16384 + hi * 512 + r32 * 16; \
    bf16x8 ka, kc, pw0, pw1, pw2, pw3; float sacc = 0.f; \
    ka = *(const LAS bf16x8*)(kb); kc = *(const LAS bf16x8*)(kb + 512); SBAR(); \
      \
    N0 = MFMA32(ka, qr[0], zero16); P0[0] = EX2(P0[0]); ka = *(const LAS bf16x8*)(kb + 2048); SBAR(); \
    N1 = MFMA32(kc, qr[0], zero16); P0[1] = EX2(P0[1]); kc = *(const LAS bf16x8*)(kb + 2048 + 512); SBAR(); \
    N0 = MFMA32(ka, qr[1], N0); P0[2] = EX2(P0[2]); ka = *(const LAS bf16x8*)(kb + 4096); SBAR(); \
    N1 = MFMA32(kc, qr[1], N1); P0[3] = EX2(P0[3]); kc = *(const LAS bf16x8*)(kb + 4096 + 512); SBAR(); \
    N0 = MFMA32(ka, qr[2], N0); P0[4] = EX2(P0[4]); sacc = fadd_s(sacc, SUM4(P0, 0)); ka = *(const LAS bf16x8*)(kb + 6144); SBAR(); \
    N1 = MFMA32(kc, qr[2], N1); P0[5] = EX2(P0[5]); kc = *(const LAS bf16x8*)(kb + 6144 + 512); SBAR(); \
    bf16x8 v0 = *(const LAS bf16x8*)(vb), v1 = *(const LAS bf16x8*)(vb + 4096), v2 = *(const LAS bf16x8*)(vb + 8192), v3 = *(const LAS bf16x8*)(vb + 12288); \
    N0 = MFMA32(ka, qr[3], N0); P0[6] = EX2(P0[6]); SBAR(); \
    N1 = MFMA32(kc, qr[3], N1); P0[7] = EX2(P0[7]); pw0 = pack8(P0, 0); SBAR(); \
    o[0] = MFMA32(pw0, v0, o[0]); P0[8] = EX2(P0[8]); P0[9] = EX2(P0[9]); sacc = fadd_s(sacc, SUM4(P0, 4)); v0 = *(const LAS bf16x8*)(vb + 1024); SBAR(); \
    o[1] = MFMA32(pw0, v1, o[1]); P0[10] = EX2(P0[10]); P0[11] = EX2(P0[11]); v1 = *(const LAS bf16x8*)(vb + 4096 + 1024); SBAR(); \
    o[2] = MFMA32(pw0, v2, o[2]); P0[12] = EX2(P0[12]); P0[13] = EX2(P0[13]); sacc = fadd_s(sacc, SUM4(P0, 8)); v2 = *(const LAS bf16x8*)(vb + 8192 + 1024); SBAR(); \
    o[3] = MFMA32(pw0, v3, o[3]); P0[14] = EX2(P0[14]); P0[15] = EX2(P0[15]); pw1 = pack8(P0, 8); v3 = *(const LAS bf16x8*)(vb + 12288 + 1024); SBAR(); \
    o[0] = MFMA32(pw1, v0, o[0]); P1[0] = EX2(P1[0]); P1[1] = EX2(P1[1]); sacc = fadd_s(sacc, SUM4(P0, 12)); v0 = *(const LAS bf16x8*)(vb + 2048); SBAR(); \
    o[1] = MFMA32(pw1, v1, o[1]); P1[2] = EX2(P1[2]); P1[3] = EX2(P1[3]); v1 = *(const LAS bf16x8*)(vb + 4096 + 2048); SBAR(); \
    o[2] = MFMA32(pw1, v2, o[2]); P1[4] = EX2(P1[4]); P1[5] = EX2(P1[5]); sacc = fadd_s(sacc, SUM4(P1, 0)); v2 = *(const LAS bf16x8*)(vb + 8192 + 2048); SBAR(); \
    o[3] = MFMA32(pw1, v3, o[3]); P1[6] = EX2(P1[6]); P1[7] = EX2(P1[7]); pw2 = pack8(P1, 0); v3 = *(const LAS bf16x8*)(vb + 12288 + 2048); SBAR(); \
    o[0] = MFMA32(pw2, v0, o[0]); P1[8] = EX2(P1[8]); P1[9] = EX2(P1[9]); sacc = fadd_s(sacc, SUM4(P1, 4)); v0 = *(const LAS bf16x8*)(vb + 3072); SBAR(); \
    o[1] = MFMA32(pw2, v1, o[1]); P1[10] = EX2(P1[10]); P1[11] = EX2(P1[11]); v1 = *(const LAS bf16x8*)(vb + 4096 + 3072); SBAR(); \
    o[2] = MFMA32(pw2, v2, o[2]); P1[12] = EX2(P1[12]); P1[13] = EX2(P1[13]); sacc = fadd_s(sacc, SUM4(P1, 8)); v2 = *(const LAS bf16x8*)(vb + 8192 + 3072); SBAR(); \
    o[3] = MFMA32(pw2, v3, o[3]); P1[14] = EX2(P1[14]); P1[15] = EX2(P1[15]); pw3 = pack8(P1, 8); v3 = *(const LAS bf16x8*)(vb + 12288 + 3072); SBAR(); \
    o[0] = MFMA32(pw3, v0, o[0]); sacc = fadd_s(sacc, SUM4(P1, 12)); glds16(kn_, (unsigned)__builtin_amdgcn_readfirstlane(ldsw + ATT_KB + s0 * 16384)); SBAR(); \
    o[1] = MFMA32(pw3, v1, o[1]); glds16(kn_ + 256 * 4096, (unsigned)__builtin_amdgcn_readfirstlane(ldsw + ATT_KB + s0 * 16384 + 8192)); SBAR(); \
    o[2] = MFMA32(pw3, v2, o[2]); glds16(vn_, (unsigned)__builtin_amdgcn_readfirstlane(ldsw + ATT_VB + s2 * 16384)); SBAR(); \
    o[3] = MFMA32(pw3, v3, o[3]); glds16(vn_ + 4096, (unsigned)__builtin_amdgcn_readfirstlane(ldsw + ATT_VB + s2 * 16384 + 8192)); \
    lsum = fadd_s(lsum, sacc); \
    if (!nomax) {       \
        float ra = max3f(N0[0], N0[1], N0[2]), rb = max3f(N1[0], N1[1], N1[2]); \
        _Pragma("unroll") for (int r = 3; r < 15; r += 2) { ra = max3f(ra, N0[r], N0[r + 1]); rb = max3f(rb, N1[r], N1[r + 1]); } \
        ra = max3f(ra, N0[15], N1[15]); \
        const float rm = swapmax(max2f(ra, rb)) - mhat; \
        if (shifted) { _Pragma("unroll") for (int r = 0; r < 16; ++r) { N0[r] -= mhat; N1[r] -= mhat; } } \
        if (t_ + 1 < T && __any(rm > ATT_THR)) { \
            shifted = true; \
            const float dl = fmaxf(rm, 0.f); mhat += dl; \
            _Pragma("unroll") for (int r = 0; r < 16; ++r) { N0[r] -= dl; N1[r] -= dl; } \
            const float f = EX2(-dl); lsum *= f; \
            if (hi == 0) wsf[r32] = f; \
            asm volatile("s_waitcnt lgkmcnt(0)" ::: "memory"); \
            _Pragma("unroll") for (int r = 0; r < 16; ++r) { const float fr = wsf[crow(r, hi)]; \
                _Pragma("unroll") for (int db = 0; db < 4; ++db) o[db][r] *= fr; } \
        } \
    } \
    ATT_WAIT_BAR(4); \
    { const int tmp_ = s0; s0 = s1; s1 = s2; s2 = tmp_; } \
} while (0)

__device__ __forceinline__ void attn_unit(const Ctx& C, const bf16* Zqkv, const bf16* Kp, const bf16* Vp, const bf16* Zbg, bf16* Bp, const float* sg, float lam, float omli, int h, int qrow0, int seqlen, const unsigned* knmax) {
    const int r32 = C.lane & 31, hi = C.lane >> 5;
    const int mapc = C.wave >> 2, wq = C.wave & 3;
    const int T = seqlen / 64, kt0 = (qrow0 / seqlen) * T;
    const bf16* Kt = Kp + (size_t)((2 * h) * 256 + kt0) * 4096;
    const bf16* Vt = Vp + (size_t)(h * 256 + kt0) * 8192;
    LAS unsigned char* lds = C.lds;
    LAS float* wsf = (LAS float*)(lds + ATT_WS) + C.wave * 64;
    const unsigned ldsw = (unsigned)(uintptr_t)lds + (unsigned)C.wave * 1024u;
    { const bf16* kn = Kt + C.tid * 8; const bf16* vn = Vt + C.tid * 8;
#pragma unroll
      for (int s = 0; s < 3; ++s) { glds16(kn + s * 4096, (unsigned)__builtin_amdgcn_readfirstlane(ldsw + ATT_KB + s * 16384));
                                    glds16(kn + 256 * 4096 + s * 4096, (unsigned)__builtin_amdgcn_readfirstlane(ldsw + ATT_KB + s * 16384 + 8192)); }
#pragma unroll
      for (int s = 0; s < 2; ++s) { glds16(vn + s * 8192, (unsigned)__builtin_amdgcn_readfirstlane(ldsw + ATT_VB + s * 16384));
                                    glds16(vn + s * 8192 + 4096, (unsigned)__builtin_amdgcn_readfirstlane(ldsw + ATT_VB + s * 16384 + 8192)); } }
    bf16x8 qr[4];
    { const bf16* qp = Zqkv + (size_t)(qrow0 + 32 * wq + r32) * 1024 + (2 * h + mapc) * 64 + 8 * hi;
#pragma unroll
      for (int d0 = 0; d0 < 4; ++d0) qr[d0] = *(const bf16x8*)(qp + 16 * d0); }
    bool nomax;
    {   float qn2 = 0.f;
#pragma unroll
        for (int d0 = 0; d0 < 4; ++d0) { const u32x4 w = __builtin_bit_cast(u32x4, qr[d0]);
            qn2 += bflo(w.x) * bflo(w.x) + bfhi(w.x) * bfhi(w.x) + bflo(w.y) * bflo(w.y) + bfhi(w.y) * bfhi(w.y)
                 + bflo(w.z) * bflo(w.z) + bfhi(w.z) * bfhi(w.z) + bflo(w.w) * bflo(w.w) + bfhi(w.w) * bfhi(w.w); }
        qn2 = swapsum(qn2);
        const float kn2 = __uint_as_float(knmax[(qrow0 / seqlen) * 16 + 2 * h + mapc]);
        nomax = !__any(qn2 * kn2 * 1.1f > ATT_THR * ATT_THR);
    }
    ATT_WAIT_BAR(0);
    int s0 = 0, s1 = 1, s2 = 2;
    f32x16 o[4];
#pragma unroll
    for (int db = 0; db < 4; ++db) o[db] = f32x16{};
    const f32x16 zero16 = f32x16{};
    float mhat = 0.f, lsum = 0.f; bool shifted = false;
    f32x16 pA0, pA1, pB0, pB1;
    {
        const LAS unsigned char* kb = lds + ATT_KB + mapc * 8192 + hi * 1024 + r32 * 16;
        pA0 = f32x16{}; pA1 = f32x16{};
#pragma unroll
        for (int d0 = 0; d0 < 4; ++d0) {
            const bf16x8 k0 = *(const LAS bf16x8*)(kb + d0 * 2048), k1 = *(const LAS bf16x8*)(kb + d0 * 2048 + 512);
            pA0 = MFMA32(k0, qr[d0], pA0); pA1 = MFMA32(k1, qr[d0], pA1);
        }
        float rm = fmaxf(pA0[0], pA1[0]);
#pragma unroll
        for (int r = 1; r < 16; ++r) rm = fmaxf(rm, fmaxf(pA0[r], pA1[r]));
        rm = swapmax(rm);
        mhat = (fabsf(rm) <= ATT_THR) ? 0.f : rm;
        shifted = __any(mhat != 0.f);
        if (shifted) {
#pragma unroll
            for (int r = 0; r < 16; ++r) { pA0[r] -= mhat; pA1[r] -= mhat; } }
    }
    asm volatile("s_waitcnt lgkmcnt(0)\n\ts_barrier" ::: "memory");
    if (mapc != 0) __builtin_amdgcn_s_setprio(1);
#pragma unroll 1
    for (int t = 0; t < T; t += 2) {
        ATT_STEP(pA0, pA1, pB0, pB1, t);
        ATT_STEP(pB0, pB1, pA0, pA1, t + 1);
    }
    __builtin_amdgcn_s_setprio(0);
    ATT_WAIT_BAR(0);
    lsum = swapsum(lsum);
    if (hi == 0) wsf[32 + r32] = 1.0f / lsum;
    asm volatile("s_waitcnt lgkmcnt(0)" ::: "memory");
    {   LAS float* st = (LAS float*)lds + (size_t)mapc * 16384 + (32 * wq) * 128 + r32;
#pragma unroll
        for (int r = 0; r < 16; ++r) { const int q = crow(r, hi); const float il = wsf[32 + q];
#pragma unroll
            for (int db = 0; db < 4; ++db) st[q * 128 + 32 * db] = o[db][r] * il; } }
    __syncthreads();
    {   const LAS float* O1 = (const LAS float*)lds; const LAS float* O2 = O1 + 16384;
        const int pc = C.tid & 15;
        const f32x4 g0 = *(const f32x4*)(sg + 8 * pc), g1 = *(const f32x4*)(sg + 8 * pc + 4);
        u32x4 gw4[4];
#pragma unroll
        for (int k = 0; k < 4; ++k) gw4[k] = *(const u32x4*)(Zbg + (size_t)(qrow0 + (C.tid >> 4) + 32 * k) * 1024 + h * 128 + 8 * pc);
#pragma unroll
        for (int k = 0; k < 4; ++k) {
            const int row = (C.tid >> 4) + 32 * k; const size_t tok = (size_t)(qrow0 + row);
            const u32x4 gw = gw4[k];
            const f32x4 a0 = *(const LAS f32x4*)(O1 + row * 128 + 8 * pc), a1 = *(const LAS f32x4*)(O1 + row * 128 + 8 * pc + 4);
            const f32x4 b0 = *(const LAS f32x4*)(O2 + row * 128 + 8 * pc), b1 = *(const LAS f32x4*)(O2 + row * 128 + 8 * pc + 4);
            float v[8];
            v[0] = a0[0] - lam * b0[0]; v[1] = a0[1] - lam * b0[1]; v[2] = a0[2] - lam * b0[2]; v[3] = a0[3] - lam * b0[3];
            v[4] = a1[0] - lam * b1[0]; v[5] = a1[1] - lam * b1[1]; v[6] = a1[2] - lam * b1[2]; v[7] = a1[3] - lam * b1[3];
            float ss = 0.f;
#pragma unroll
            for (int i = 0; i < 8; ++i) ss += v[i] * v[i];
            ss += __shfl_xor(ss, 1); ss += __shfl_xor(ss, 2); ss += __shfl_xor(ss, 4); ss += __shfl_xor(ss, 8);
            const float rstd = rsqrtf(ss * (1.0f / 128) + RMS_EPS) * omli;
            u32x4 w;
            w.x = pk2(v[0] * rstd * g0[0] * siluf_(bflo(gw.x)), v[1] * rstd * g0[1] * siluf_(bfhi(gw.x)));
            w.y = pk2(v[2] * rstd * g0[2] * siluf_(bflo(gw.y)), v[3] * rstd * g0[3] * siluf_(bfhi(gw.y)));
            w.z = pk2(v[4] * rstd * g1[0] * siluf_(bflo(gw.z)), v[5] * rstd * g1[1] * siluf_(bfhi(gw.z)));
            w.w = pk2(v[6] * rstd * g1[2] * siluf_(bflo(gw.w)), v[7] * rstd * g1[3] * siluf_(bfhi(gw.w)));
            *(u32x4*)(Bp + tok * 1024 + h * 128 + 8 * pc) = w;
        }
    }
    __syncthreads();
}
__device__ __forceinline__ void phase_attn(const Ctx& C, const bf16* Zqkv, const bf16* Kp, const bf16* Vp, const bf16* Zbg, bf16* Bp,
                                           const float* lq1, const float* lk1, const float* lq2, const float* lk2, const float* sg, int layer, int seqlen, const unsigned* knmax) {
    float d1 = 0.f, d2 = 0.f;
    for (int i = 0; i < 64; ++i) { d1 += lq1[i] * lk1[i]; d2 += lq2[i] * lk2[i]; }
    const float lam_init = 0.8f - 0.6f * expf(-0.3f * (float)layer);
    const float lam = expf(d1) - expf(d2) + lam_init;
    if (C.G == 256) {
        const int h = C.b & 7, slot = C.b >> 3;
        for (int i = 0; i < 4; ++i) attn_unit(C, Zqkv, Kp, Vp, Zbg, Bp, sg, lam, 1.0f - lam_init, h, (i * 32 + slot) * 128, seqlen, knmax);
    } else {
        for (int u = C.b; u < 1024; u += C.G) attn_unit(C, Zqkv, Kp, Vp, Zbg, Bp, sg, lam, 1.0f - lam_init, u & 7, (u >> 3) * 128, seqlen, knmax);
    }
}
#define XB_TMO      128
#define XB_XCNT(j)  (256  + 64 * (j))
#define XB_XSUB(j)  (1280 + 64 * (j))
#define XB_XGEN(j)  (2304 + 64 * (j))
#define XB_TOP      3328
#define XB_TOPGEN   3392
#define XCD_BAR_WORDS 3456
#define XB_SPIN_CAP (1u << 22)

__device__ __forceinline__ unsigned xb_ld(unsigned* p)              { return __hip_atomic_load(p, __ATOMIC_RELAXED, __HIP_MEMORY_SCOPE_AGENT); }
__device__ __forceinline__ unsigned xb_add(unsigned* p, unsigned v) { return __hip_atomic_fetch_add(p, v, __ATOMIC_RELAXED, __HIP_MEMORY_SCOPE_AGENT); }
__device__ __forceinline__ unsigned xb_xcc_id() { return (unsigned)__builtin_amdgcn_s_getreg((3 << 11) | 20) & 0xFu; }
#define XB_SPIN(cond, bar) do { unsigned _sp = 0; while (cond) { __builtin_amdgcn_s_sleep(1); \
    if ((++_sp & 255u) == 0u) { if (xb_ld(&(bar)[XB_TMO])) break; if (_sp > XB_SPIN_CAP) { atomicAdd(&(bar)[XB_TMO], 1u); break; } } } } while (0)

struct XcdBarrier {
    unsigned* bar; unsigned x;
    volatile LAS unsigned* st;
};

__device__ __forceinline__ XcdBarrier xcd_barrier_post(unsigned* bar, volatile LAS unsigned* st) {
    XcdBarrier b; b.bar = bar; b.x = xb_xcc_id(); b.st = st;
    if (threadIdx.x == 0) (void)xb_add(&bar[XB_XCNT(b.x)], 1u);
    return b;
}
__device__ __forceinline__ void xcd_barrier_complete(unsigned* bar, unsigned x, unsigned& nloc, unsigned& nx) {
    const unsigned G = gridDim.x * gridDim.y * gridDim.z;
    unsigned sum, cnt, mine, sp = 0u;
    for (;;) {
        sum = 0u; cnt = 0u; mine = 0u;
#pragma unroll
        for (unsigned j = 0; j < 16; ++j) { const unsigned c = xb_ld(&bar[XB_XCNT(j)]); sum += c; cnt += (c > 0u) ? 1u : 0u; mine = (j == x) ? c : mine; }
        if (sum == G) break;
        __builtin_amdgcn_s_sleep(1);
        if ((++sp & 255u) == 0u) { if (xb_ld(&bar[XB_TMO])) break; if (sp > XB_SPIN_CAP) { atomicAdd(&bar[XB_TMO], 1u); break; } }
    }
    nloc = mine > 0u ? mine : 1u; nx = cnt > 0u ? cnt : 1u;
}

__device__ __forceinline__ void xcd_barrier(const XcdBarrier& b) {
    asm volatile("s_waitcnt vmcnt(0)" ::: "memory");
    __syncthreads();
    if (threadIdx.x == 0) {
        unsigned* bar = b.bar;
        __builtin_amdgcn_s_waitcnt(0);
        unsigned nloc = b.st[0], nx = b.st[1];
        if (nloc == 0u) { xcd_barrier_complete(bar, b.x, nloc, nx); b.st[0] = nloc; b.st[1] = nx; }
        const unsigned old = xb_add(&bar[XB_XSUB(b.x)], 1u);
        const unsigned gen = old / nloc;
        if (old + 1u == (gen + 1u) * nloc) {
            __builtin_amdgcn_fence(__ATOMIC_RELEASE, "agent");
            asm volatile("s_waitcnt vmcnt(0)" ::: "memory");
            const unsigned og = xb_add(&bar[XB_TOP], 1u);
            const unsigned tg = og / nx;
            if (og + 1u == (tg + 1u) * nx) xb_add(&bar[XB_TOPGEN], 1u);
            else XB_SPIN(xb_ld(&bar[XB_TOPGEN]) == tg, bar);
            __builtin_amdgcn_fence(__ATOMIC_ACQUIRE, "agent");
            xb_add(&bar[XB_XGEN(b.x)], 1u);
            asm volatile("s_waitcnt vmcnt(0)" ::: "memory");
        } else {
            XB_SPIN(xb_ld(&bar[XB_XGEN(b.x)]) == gen, bar);
            __builtin_amdgcn_fence(__ATOMIC_ACQUIRE, "agent");
            asm volatile("s_waitcnt vmcnt(0)" ::: "memory");
        }
    }
    __syncthreads();
}
constexpr size_t WS_BAR = 0;
constexpr int LDS_ST = LDS_TAB + 256;
constexpr int PH_PER_GROUP = 8, N_PHASES = 1 + NGROUPS * PH_PER_GROUP;
__global__ void __launch_bounds__(NTHREADS, 2) fwd_kernel(Params p) {
    extern __shared__ __attribute__((aligned(16))) unsigned char lds_raw[];
    { const int t0 = threadIdx.x; if (t0 == 0) { LAS double* tab = (LAS double*)((LAS unsigned char*)lds_raw + LDS_TAB);
#pragma unroll
        for (int i = 0; i < 32; ++i) tab[i] = p.invrev[i]; } }
    if (blockIdx.x == 0) { unsigned* bw = (unsigned*)(p.ws + WS_BAR); for (int i = threadIdx.x; i < XCD_BAR_WORDS; i += NTHREADS) bw[i] = 0u; }
    if (blockIdx.x == 0 && threadIdx.x < 384) ((unsigned*)(p.ws + WS_PCNT))[threadIdx.x] = 0u;
    if (threadIdx.x < 2) ((volatile LAS unsigned*)((LAS unsigned char*)lds_raw + LDS_ST))[threadIdx.x] = 0u;
    __syncthreads();
    XcdBarrier bar; bar.bar = (unsigned*)(p.ws + WS_BAR); bar.x = 0; bar.st = (volatile LAS unsigned*)((LAS unsigned char*)lds_raw + LDS_ST);
    for (int ph = p.ph_lo; ph < p.ph_hi; ++ph) {
        int tid_ = threadIdx.x; asm volatile("" : "+v"(tid_));
        int bid_ = blockIdx.x; asm volatile("" : "+s"(bid_));
        size_t wz_ = 0; asm volatile("" : "+s"(wz_));
        unsigned char* ws = p.ws + wz_;
        Ctx C; C.lds = (LAS unsigned char*)lds_raw; C.tid = tid_; C.lane = C.tid & 63; C.wave = __builtin_amdgcn_readfirstlane(C.tid >> 6); C.G = gridDim.x; C.b = bid_;
        bf16* R1 = (bf16*)(ws + WS_R1); bf16* Zqkv = (bf16*)(ws + WS_ZQKV); bf16* Kp = (bf16*)(ws + WS_ZQKV + 32 * MiB); bf16* Za = (bf16*)(ws + WS_ZA); bf16* Zc = (bf16*)(ws + WS_ZC);
        bf16* Zbg = (bf16*)(ws + WS_ZBG); bf16* Zm = (bf16*)(ws + WS_ZM); bf16* Ap = (bf16*)(ws + WS_AP); bf16* Cp = Ap; bf16* Vp = (bf16*)(ws + WS_VP);
        bf16* Bp = (bf16*)(ws + WS_ZQKV + 64 * MiB);
        if (ph == 0) {
            phase_weights(C, p);
            __syncthreads();
            phase_norm_in(C, p.in[0], p.in[2], R1, (unsigned*)(ws + WS_KNMAX));
        }
        else {
            const int k = ph - 1, gi = k / PH_PER_GROUP, r = k % PH_PER_GROUP;
            const int seqlen = gi == 0 ? 16384 : 2048;
            float* xout = p.out + (size_t)gi * GT * DM;
            {
                const int l = r >> 2, s = (r & 3) + 1;
                const float* xin = l == 0 ? (gi == 0 ? p.in[0] : p.in[1] + (size_t)(gi - 1) * GT * DM) : xout;
                if (false) { }
                else if (s == 1) {
                    pg8::Gemm g{(l == 0 && gi > 0) ? Bp : R1, (const bf16*)(ws + WS_WIN) + (size_t)l * INC * 1024, GT, INC, 1024}; pg8::StaticOrder S; S.init(GT, INC, C.G, C.b);
                    EpiZ E{Zqkv, Kp, Vp, Za, Zc, Zbg, Zm, (const LAS double*)(C.lds + LDS_TAB), seqlen, (unsigned*)(ws + WS_KNMAX)};
#ifndef DIS_G1
                    pg8::gemm_phase<EpiZ, pg8::StaticOrder, true, true>(C.lds, g, S, E, C.tid);
#endif
                } else if (s == 2) {
#ifndef DIS_CONV
                    phase_conv(C, Za, Ap, p.in[4] + l * 31 * 512, p.in[5] + l * 512, p.in[6] + l * 512, seqlen);
#endif
                    __syncthreads();
#ifndef DIS_SGU
                    phase_sgu(C, Zc, Cp, p.in[14] + l * 512, p.in[15] + (size_t)l * 4 * 128 * 128, p.in[16] + l * 512);
#endif
                    __syncthreads();
#ifndef DIS_ATT
 phase_attn(C, Zqkv, Kp, Vp, Zbg, Bp, p.in[8] + l * 64, p.in[9] + l * 64, p.in[10] + l * 64, p.in[11] + l * 64, p.in[12] + l * 128, l, seqlen, (const unsigned*)(ws + WS_KNMAX));
#endif
                }
                else if (s == 3) {
                    SegOrder S; S.so.init(GT, DM, C.G, C.b); S.AC = Ap; S.B = Bp; S.WAC = (const bf16*)(ws + WS_WAC) + (size_t)l * 1024 * 1024; S.WB = (const bf16*)(ws + WS_WB) + (size_t)l * 1024 * 1024;
                    pg8::Gemm g{Ap, S.WAC, GT, DM, 1024};
                    EpiGate3 E{Zm, R1};
#ifndef DIS_G5
                    pg8::gemm_phase_seg<EpiGate3, SegOrder, true, true>(C.lds, g, S, E, C.tid);
#endif
                } else {
                    pg8::Gemm g{R1, (const bf16*)(ws + WS_WO) + (size_t)l * 1024 * 1024, GT, DM, 1024}; pg8::StaticOrder S; S.init(GT, DM, C.G, C.b);
                    EpiResNorm E{xin, xout, l == 0 ? R1 : nullptr, l == 0 ? p.in[2] + DM : p.in[19], (unsigned*)(ws + WS_SLOTS), (unsigned*)(ws + WS_PCNT) + (gi * 2 + l) * 64};
                    pg8::gemm_phase<EpiResNorm, pg8::StaticOrder, false, true>(C.lds, g, S, E, C.tid);
                    if (l == 0 && C.b == 0 && C.tid < 128) ((unsigned*)(ws + WS_KNMAX))[C.tid] = 0u;
                    if (l == 1 && gi + 1 < NGROUPS) {
                        __syncthreads();
                        phase_norm_in(C, p.in[1] + (size_t)gi * GT * DM, p.in[2], Bp, (unsigned*)(ws + WS_KNMAX));
                    }
                }
            }
        }
        if (ph + 1 < p.ph_hi) {
            if (ph == p.ph_lo) { cg::this_grid().sync(); bar = xcd_barrier_post((unsigned*)(p.ws + WS_BAR), (volatile LAS unsigned*)((LAS unsigned char*)lds_raw + LDS_ST)); }
            else xcd_barrier(bar);
        }
    }
}


#ifndef ONE_LAUNCH
#define ONE_LAUNCH 1
#endif
extern "C" void kernel_launch(void* const* d_in, const int* in_sizes, int n_in, void* d_out, int out_size, void* d_ws, size_t ws_size, hipStream_t stream) {
    static int grid = 0;
    if (grid == 0) {
        if (n_in != 20 || out_size != 3 * GT * DM || ws_size < WS_END) { fprintf(stderr, "kernel_launch: unexpected shapes n_in %d out %d ws %zu\n", n_in, out_size, ws_size); grid = -1; return; }
        int dev = 0, cus = 0, per_cu = 0;
        hipGetDevice(&dev); hipDeviceGetAttribute(&cus, hipDeviceAttributeMultiprocessorCount, dev);
        hipFuncSetAttribute((const void*)fwd_kernel, hipFuncAttributeMaxDynamicSharedMemorySize, LDS_BYTES);
        hipOccupancyMaxActiveBlocksPerMultiprocessor(&per_cu, (const void*)fwd_kernel, NTHREADS, LDS_BYTES);
        if (per_cu < 1) { fprintf(stderr, "kernel_launch: occupancy query says %d blocks per CU\n", per_cu); per_cu = 1; }
        if (cus != 256) { fprintf(stderr, "kernel_launch: built for a 256-CU device (got %d CUs); nothing launched\n", cus); grid = -1; return; }
        grid = cus * 1;
        (void)hipGetLastError();
    }
    if (grid < 0) return;
    Params p{};
    for (int i = 0; i < 20; ++i) p.in[i] = (const float*)d_in[i];
    p.out = (float*)d_out; p.ws = (unsigned char*)d_ws;
    for (int i = 0; i < 32; ++i) p.invrev[i] = pow(10000.0, -(double)i / 32.0) / (2.0 * M_PI);
#if ONE_LAUNCH
    p.ph_lo = 0; p.ph_hi = N_PHASES;
    void* args[] = {&p};
    hipError_t e = hipLaunchCooperativeKernel((const void*)fwd_kernel, dim3(grid), dim3(NTHREADS), args, LDS_BYTES, stream);
    if (e != hipSuccess) fprintf(stderr, "cooperative launch failed: %s (grid %d)\n", hipGetErrorString(e), grid);
#ifdef PROBE_T
    for (int rep = 0; rep < PROBE_N; ++rep) {
        if (PROBE_T == 8) { hipFuncSetAttribute((const void*)probe_kernel<PROBE_T>, hipFuncAttributeMaxDynamicSharedMemorySize, LDS_BYTES); hipLaunchCooperativeKernel((const void*)probe_kernel<PROBE_T>, dim3(grid), dim3(NTHREADS), args, LDS_BYTES, stream); }
        else hipLaunchKernelGGL(probe_kernel<PROBE_T>, dim3(grid), dim3(NTHREADS), LDS_BYTES, stream, p);
    }
#endif
#else
    for (int ph = 0; ph < N_PHASES; ++ph) { p.ph_lo = ph; p.ph_hi = ph + 1; hipLaunchKernelGGL(fwd_kernel, dim3(grid), dim3(NTHREADS), LDS_BYTES, stream, p); }
#endif
}
```

```cpp
#include <hip/hip_runtime.h>
#include <hip/hip_cooperative_groups.h>
#include <cstdio>
#include <cstdint>
#include <cmath>
namespace pg8 {
#define PG8_LAS __attribute__((address_space(3)))
typedef unsigned short bf16_t;
typedef short bf16x8 __attribute__((ext_vector_type(8)));
typedef float f32x4 __attribute__((ext_vector_type(4)));
typedef unsigned u32x4 __attribute__((ext_vector_type(4)));
constexpr int BM = 256, BK = 64, HALF = 128, HTB = HALF * BK * 2  , STAGE_BYTES = 8 * HTB, NXCD = 8, WGM = 4;

__host__ __device__ __forceinline__ int lds_byte(int r, int c) { const int st = (r >> 4) * 2 + (c >> 5), rr = r & 15, cc = c & 31, ob = rr * 64 + cc * 2; return st * 1024 + (ob ^ (((ob >> 9) & 1) << 5)); }
__host__ __device__ __forceinline__ void stage_rc(int b, int& R, int& C) { const int st = b / 1024, sb = b % 1024, swz = sb ^ (((sb >> 9) & 1) << 5); R = (st >> 1) * 16 + swz / 64; C = (st & 1) * 32 + (swz % 64) / 2; }
__host__ __device__ __forceinline__ int perm32(int rho) { const int n = rho >> 4, i = rho & 15; return 8 * (i >> 2) + 4 * n + (i & 3); }

struct Unit { int pm, pn, seg; };
struct Gemm { const bf16_t* A; const bf16_t* Bt; int M, N, K; };

struct StaticOrder {
    int nM, nN, nwg, G, c;
    __host__ __device__ void init(int M, int N, int G_, int c_) { nM = M / BM; nN = N / BM; nwg = nM * nN; G = G_; c = c_; }
    __host__ __device__ bool next(int i, Unit& u) const {
        const long L = (long)i * G + c; if (L >= nwg) return false;
        int wgid = (int)L; { const int q = nwg / NXCD, r = nwg % NXCD, xcd = wgid % NXCD, off = wgid / NXCD; wgid = (xcd < r ? xcd * (q + 1) : r * (q + 1) + (xcd - r) * q) + off; }
        const int nig = WGM * nN, gid = wgid / nig, fm = gid * WGM, gsz = (nM - fm) < WGM ? (nM - fm) : WGM;
        u.pm = fm + ((wgid % nig) % gsz); u.pn = (wgid % nig) / gsz; return true;
    }
    __device__ __forceinline__ void a_ready(const Unit&) const {}
    __device__ __forceinline__ void done(const Unit&) const {}
};

__device__ __forceinline__ unsigned cvt_pk_bf16(float lo, float hi) { unsigned r; asm volatile("v_cvt_pk_bf16_f32 %0, %1, %2" : "=v"(r) : "v"(lo), "v"(hi)); return r; }
template <class Epi, class Sched, bool ALIGN_EPI = false, bool SP2 = false>
__device__ __forceinline__ void gemm_phase(PG8_LAS unsigned char* lds, const Gemm g, const Sched& S, const Epi& E, const int tid_in) {
    const int tid = tid_in, wid = __builtin_amdgcn_readfirstlane(tid >> 6), lane = tid & 63, wr = wid >> 2, wc = wid & 3, fr = lane & 15, fq = lane >> 4;
    const int K = g.K, nt = K / BK;
    unsigned voffA[2], voffB[2];
#pragma unroll
    for (int i = 0; i < 2; ++i) { int R, C; stage_rc(tid * 16 + i * 8192, R, C); const int Rb = Epi::PERM ? ((R & ~31) + perm32(R & 31)) : R;
        voffA[i] = (unsigned)(R * K + C) * 2u; voffB[i] = (unsigned)(Rb * K + C) * 2u; }
    const size_t kstep = (size_t)(BK * 2);
    const size_t hstep = (size_t)HALF * K * 2;
    const size_t tstep = 2 * hstep;
    const unsigned ldsw = (unsigned)wid * 1024u;
    const int aoff = lds_byte(wr * 64 + fr, fq * 8), boff = lds_byte(wc * 32 + fr, fq * 8);
#define PG8_SA(b, h) (((b) * 2 + (h)) * HTB)
#define PG8_SB(b, h) ((4 + (b) * 2 + (h)) * HTB)
#define PG8_STAGE(bufoff, gbase, voff) do { _Pragma("unroll") for (int _i = 0; _i < 2; ++_i) \
        __builtin_amdgcn_global_load_lds((const unsigned*)((const char*)(gbase) + (voff)[_i]), (PG8_LAS unsigned*)(lds + (bufoff) + ldsw + _i * 8192), 16, 0, 0); } while (0)
#define PG8_LDA(dst, b, h) do { _Pragma("unroll") for (int m = 0; m < 4; ++m) _Pragma("unroll") for (int k = 0; k < 2; ++k) dst[m][k] = *(const PG8_LAS bf16x8*)(lds + PG8_SA(b, h) + aoff + m * 2048 + k * 1024); } while (0)
#define PG8_LDB(dst, b, h) do { _Pragma("unroll") for (int n = 0; n < 2; ++n) _Pragma("unroll") for (int k = 0; k < 2; ++k) dst[n][k] = *(const PG8_LAS bf16x8*)(lds + PG8_SB(b, h) + boff + n * 2048 + k * 1024); } while (0)
#define PG8_MMA(ai, bj, At, Bt) do { __builtin_amdgcn_s_setprio(1); _Pragma("unroll") for (int m = 0; m < 4; ++m) _Pragma("unroll") for (int n = 0; n < 2; ++n) _Pragma("unroll") for (int k = 0; k < 2; ++k) \
        acc[ai][bj][m][n] = __builtin_amdgcn_mfma_f32_16x16x32_bf16(Bt[n][k], At[m][k], acc[ai][bj][m][n], 0, 0, 0); __builtin_amdgcn_s_setprio(0); } while (0)
#define PG8_WAIT_V(n) asm volatile("s_waitcnt vmcnt(" #n ")" ::: "memory")
#define PG8_WAIT_L(n) asm volatile("s_waitcnt lgkmcnt(" #n ")" ::: "memory")
#define PG8_BAR __builtin_amdgcn_s_barrier()
#define PG8_SCHED __builtin_amdgcn_sched_barrier(0)
    Unit cur, nxt; int ui = 0;
    if (!S.next(0, cur)) return;
    f32x4 acc[2][2][4][2];
#pragma unroll
    for (int a = 0; a < 2; ++a)
#pragma unroll
        for (int b = 0; b < 2; ++b)
#pragma unroll
            for (int m = 0; m < 4; ++m)
#pragma unroll
                for (int n = 0; n < 2; ++n) acc[a][b][m][n] = (f32x4){0.f, 0.f, 0.f, 0.f};
    bf16x8 At[4][2], B0[2][2], B1[2][2];
    const char* cA = (const char*)g.A + (size_t)cur.pm * tstep; const char* cB = (const char*)g.Bt + (size_t)cur.pn * tstep;
    S.a_ready(cur);
    if constexpr (SP2) {
        PG8_STAGE(PG8_SB(0, 0), cB, voffB); PG8_STAGE(PG8_SB(0, 1), cB + hstep, voffB); PG8_STAGE(PG8_SA(0, 0), cA, voffA); PG8_STAGE(PG8_SA(0, 1), cA + hstep, voffA);
        if (wr == 1) PG8_BAR;
        PG8_WAIT_V(2); PG8_BAR;
        PG8_STAGE(PG8_SB(1, 0), cB + kstep, voffB); PG8_STAGE(PG8_SA(1, 0), cA + kstep, voffA); PG8_STAGE(PG8_SB(1, 1), cB + hstep + kstep, voffB);
        PG8_WAIT_V(6); PG8_BAR;
    } else {
        PG8_STAGE(PG8_SB(0, 0), cB, voffB); PG8_STAGE(PG8_SA(0, 0), cA, voffA); PG8_STAGE(PG8_SB(0, 1), cB + hstep, voffB); PG8_STAGE(PG8_SA(0, 1), cA + hstep, voffA);
        if (wr == 1) PG8_BAR;
        PG8_WAIT_V(4); PG8_BAR;
        PG8_STAGE(PG8_SB(1, 0), cB + kstep, voffB); PG8_STAGE(PG8_SA(1, 0), cA + kstep, voffA); PG8_STAGE(PG8_SB(1, 1), cB + hstep + kstep, voffB);
        PG8_WAIT_V(6); PG8_BAR;
    }
    for (;;) {
        const bool has_next = S.next(ui + 1, nxt);
        const char* nA = has_next ? (const char*)g.A + (size_t)nxt.pm * tstep : cA; const char* nB = has_next ? (const char*)g.Bt + (size_t)nxt.pn * tstep : cB;
        for (int t = 0; t < nt; t += 2) {
            const bool last = (t == nt - 2);
            const char* a1 = cA + (size_t)(t + 1) * kstep;
            const char* a2 = last ? nA : cA + (size_t)(t + 2) * kstep; const char* b2 = last ? nB : cB + (size_t)(t + 2) * kstep;
            const char* a3 = a2 + kstep; const char* b3 = b2 + kstep;
            if (last && has_next) S.a_ready(nxt);
            if constexpr (SP2) {
            PG8_LDB(B0, 0, 0); PG8_LDB(B1, 0, 1); PG8_SCHED; PG8_LDA(At, 0, 0); PG8_STAGE(PG8_SA(1, 1), a1 + hstep, voffA);
            PG8_WAIT_V(8); PG8_WAIT_L(0); PG8_BAR; PG8_MMA(0, 0, At, B0); PG8_MMA(0, 1, At, B1); PG8_BAR; PG8_SCHED;
            PG8_LDA(At, 0, 1); PG8_STAGE(PG8_SB(0, 0), b2, voffB); PG8_STAGE(PG8_SB(0, 1), b2 + hstep, voffB); PG8_STAGE(PG8_SA(0, 0), a2, voffA);
            PG8_WAIT_V(8); PG8_WAIT_L(0); PG8_BAR; PG8_MMA(1, 0, At, B0); PG8_MMA(1, 1, At, B1); PG8_BAR; PG8_SCHED;
            PG8_LDB(B0, 1, 0); PG8_LDB(B1, 1, 1); PG8_SCHED; PG8_LDA(At, 1, 0); PG8_STAGE(PG8_SA(0, 1), a2 + hstep, voffA);
            PG8_WAIT_V(8); PG8_WAIT_L(0); PG8_BAR; PG8_MMA(0, 0, At, B0); PG8_MMA(0, 1, At, B1); PG8_BAR; PG8_SCHED;
            PG8_LDA(At, 1, 1); PG8_STAGE(PG8_SB(1, 0), b3, voffB); PG8_STAGE(PG8_SB(1, 1), b3 + hstep, voffB); PG8_STAGE(PG8_SA(1, 0), a3, voffA);
            PG8_WAIT_V(8); PG8_WAIT_L(0); PG8_BAR; PG8_MMA(1, 0, At, B0); PG8_MMA(1, 1, At, B1); PG8_BAR; PG8_SCHED;
            } else {
            PG8_LDB(B0, 0, 0); PG8_SCHED; PG8_LDA(At, 0, 0); PG8_STAGE(PG8_SA(1, 1), a1 + hstep, voffA);
            PG8_WAIT_L(8); PG8_BAR; PG8_WAIT_L(0); PG8_MMA(0, 0, At, B0); PG8_BAR; PG8_SCHED;
            PG8_LDB(B1, 0, 1); PG8_STAGE(PG8_SB(0, 0), b2, voffB);
            PG8_BAR; PG8_WAIT_L(0); PG8_MMA(0, 1, At, B1); PG8_BAR;
            PG8_LDA(At, 0, 1); PG8_STAGE(PG8_SA(0, 0), a2, voffA);
            PG8_BAR; PG8_WAIT_L(0); PG8_MMA(1, 0, At, B0); PG8_BAR; PG8_SCHED;
            PG8_STAGE(PG8_SB(0, 1), b2 + hstep, voffB);
            PG8_WAIT_V(6); PG8_BAR; PG8_MMA(1, 1, At, B1); PG8_BAR;
            PG8_LDB(B0, 1, 0); PG8_SCHED; PG8_LDA(At, 1, 0); PG8_STAGE(PG8_SA(0, 1), a2 + hstep, voffA);
            PG8_WAIT_L(8); PG8_BAR; PG8_WAIT_L(0); PG8_MMA(0, 0, At, B0); PG8_BAR; PG8_SCHED;
            PG8_LDB(B1, 1, 1); PG8_STAGE(PG8_SB(1, 0), b3, voffB);
            PG8_BAR; PG8_WAIT_L(0); PG8_MMA(0, 1, At, B1); PG8_BAR;
            PG8_LDA(At, 1, 1); PG8_STAGE(PG8_SA(1, 0), a3, voffA);
            PG8_BAR; PG8_WAIT_L(0); PG8_MMA(1, 0, At, B0); PG8_BAR; PG8_SCHED;
            PG8_STAGE(PG8_SB(1, 1), b3 + hstep, voffB);
            PG8_WAIT_V(6); PG8_BAR; PG8_MMA(1, 1, At, B1); PG8_BAR;
            }
        }
        if constexpr (ALIGN_EPI) { if (wr == 0) PG8_BAR; }
        if constexpr (!Epi::AFTER_DRAIN) { E(acc, cur, wr, wc, fr, fq); S.done(cur); }
        if (!has_next) break;
#pragma unroll
        for (int a = 0; a < 2; ++a)
#pragma unroll
            for (int b = 0; b < 2; ++b)
#pragma unroll
                for (int m = 0; m < 4; ++m)
#pragma unroll
                    for (int n = 0; n < 2; ++n) acc[a][b][m][n] = (f32x4){0.f, 0.f, 0.f, 0.f};
        cur = nxt; cA = nA; cB = nB; ++ui;
        if constexpr (ALIGN_EPI) { if (wr == 1) PG8_BAR; }
    }
    PG8_WAIT_V(0);
    if constexpr (!ALIGN_EPI) { if (wr == 0) PG8_BAR; }
    PG8_BAR;
    if constexpr (Epi::AFTER_DRAIN) { E.fused(acc, cur, wr, wc, fr, fq, lds, wid, lane); S.done(cur); }
#undef PG8_SA
#undef PG8_SB
#undef PG8_STAGE
#undef PG8_LDA
#undef PG8_LDB
#undef PG8_MMA
#undef PG8_WAIT_V
#undef PG8_WAIT_L
#undef PG8_BAR
#undef PG8_SCHED
}
template <class Epi, class Sched, bool ALIGN_EPI = false, bool SP2 = false>
__device__ __forceinline__ void gemm_phase_seg(PG8_LAS unsigned char* lds, const Gemm g, const Sched& S, const Epi& E, const int tid_in) {
    const int tid = tid_in, wid = __builtin_amdgcn_readfirstlane(tid >> 6), lane = tid & 63, wr = wid >> 2, wc = wid & 3, fr = lane & 15, fq = lane >> 4;
    const int K = g.K; int nt;
    unsigned voffA[2], voffB[2];
#pragma unroll
    for (int i = 0; i < 2; ++i) { int R, C; stage_rc(tid * 16 + i * 8192, R, C); const int Rb = Epi::PERM ? ((R & ~31) + perm32(R & 31)) : R;
        voffA[i] = (unsigned)(R * K + C) * 2u; voffB[i] = (unsigned)(Rb * K + C) * 2u; }
    const size_t kstep = (size_t)(BK * 2);
    const size_t hstep = (size_t)HALF * K * 2;
    const size_t tstep = 2 * hstep;
    const unsigned ldsw = (unsigned)wid * 1024u;
    const int aoff = lds_byte(wr * 64 + fr, fq * 8), boff = lds_byte(wc * 32 + fr, fq * 8);
#define PG8_SA(b, h) (((b) * 2 + (h)) * HTB)
#define PG8_SB(b, h) ((4 + (b) * 2 + (h)) * HTB)
#define PG8_STAGE(bufoff, gbase, voff) do { _Pragma("unroll") for (int _i = 0; _i < 2; ++_i) \
        __builtin_amdgcn_global_load_lds((const unsigned*)((const char*)(gbase) + (voff)[_i]), (PG8_LAS unsigned*)(lds + (bufoff) + ldsw + _i * 8192), 16, 0, 0); } while (0)
#define PG8_LDA(dst, b, h) do { _Pragma("unroll") for (int m = 0; m < 4; ++m) _Pragma("unroll") for (int k = 0; k < 2; ++k) dst[m][k] = *(const PG8_LAS bf16x8*)(lds + PG8_SA(b, h) + aoff + m * 2048 + k * 1024); } while (0)
#define PG8_LDB(dst, b, h) do { _Pragma("unroll") for (int n = 0; n < 2; ++n) _Pragma("unroll") for (int k = 0; k < 2; ++k) dst[n][k] = *(const PG8_LAS bf16x8*)(lds + PG8_SB(b, h) + boff + n * 2048 + k * 1024); } while (0)
#define PG8_MMA(ai, bj, At, Bt) do { __builtin_amdgcn_s_setprio(1); _Pragma("unroll") for (int m = 0; m < 4; ++m) _Pragma("unroll") for (int n = 0; n < 2; ++n) _Pragma("unroll") for (int k = 0; k < 2; ++k) \
        acc[ai][bj][m][n] = __builtin_amdgcn_mfma_f32_16x16x32_bf16(Bt[n][k], At[m][k], acc[ai][bj][m][n], 0, 0, 0); __builtin_amdgcn_s_setprio(0); } while (0)
#define PG8_WAIT_V(n) asm volatile("s_waitcnt vmcnt(" #n ")" ::: "memory")
#define PG8_WAIT_L(n) asm volatile("s_waitcnt lgkmcnt(" #n ")" ::: "memory")
#define PG8_BAR __builtin_amdgcn_s_barrier()
#define PG8_SCHED __builtin_amdgcn_sched_barrier(0)
    Unit cur, nxt; int ui = 0;
    if (!S.next(0, cur)) return;
    f32x4 acc[2][2][4][2];
#pragma unroll
    for (int a = 0; a < 2; ++a)
#pragma unroll
        for (int b = 0; b < 2; ++b)
#pragma unroll
            for (int m = 0; m < 4; ++m)
#pragma unroll
                for (int n = 0; n < 2; ++n) acc[a][b][m][n] = (f32x4){0.f, 0.f, 0.f, 0.f};
    bf16x8 At[4][2], B0[2][2], B1[2][2];
    const char* cA = S.aptr(cur, tstep); const char* cB = S.bptr(cur, tstep); nt = S.nt(cur);
    S.a_ready(cur);
    if constexpr (SP2) {
        PG8_STAGE(PG8_SB(0, 0), cB, voffB); PG8_STAGE(PG8_SB(0, 1), cB + hstep, voffB); PG8_STAGE(PG8_SA(0, 0), cA, voffA); PG8_STAGE(PG8_SA(0, 1), cA + hstep, voffA);
        if (wr == 1) PG8_BAR;
        PG8_WAIT_V(2); PG8_BAR;
        PG8_STAGE(PG8_SB(1, 0), cB + kstep, voffB); PG8_STAGE(PG8_SA(1, 0), cA + kstep, voffA); PG8_STAGE(PG8_SB(1, 1), cB + hstep + kstep, voffB);
        PG8_WAIT_V(6); PG8_BAR;
    } else {
        PG8_STAGE(PG8_SB(0, 0), cB, voffB); PG8_STAGE(PG8_SA(0, 0), cA, voffA); PG8_STAGE(PG8_SB(0, 1), cB + hstep, voffB); PG8_STAGE(PG8_SA(0, 1), cA + hstep, voffA);
        if (wr == 1) PG8_BAR;
        PG8_WAIT_V(4); PG8_BAR;
        PG8_STAGE(PG8_SB(1, 0), cB + kstep, voffB); PG8_STAGE(PG8_SA(1, 0), cA + kstep, voffA); PG8_STAGE(PG8_SB(1, 1), cB + hstep + kstep, voffB);
        PG8_WAIT_V(6); PG8_BAR;
    }
    for (;;) {
        const bool has_next = S.next(ui + 1, nxt);
        const char* nA = has_next ? S.aptr(nxt, tstep) : cA; const char* nB = has_next ? S.bptr(nxt, tstep) : cB;
        for (int t = 0; t < nt; t += 2) {
            const bool last = (t == nt - 2);
            const char* a1 = cA + (size_t)(t + 1) * kstep;
            const char* a2 = last ? nA : cA + (size_t)(t + 2) * kstep; const char* b2 = last ? nB : cB + (size_t)(t + 2) * kstep;
            const char* a3 = a2 + kstep; const char* b3 = b2 + kstep;
            if (last && has_next) S.a_ready(nxt);
            if constexpr (SP2) {
            PG8_LDB(B0, 0, 0); PG8_LDB(B1, 0, 1); PG8_SCHED; PG8_LDA(At, 0, 0); PG8_STAGE(PG8_SA(1, 1), a1 + hstep, voffA);
            PG8_WAIT_V(8); PG8_WAIT_L(0); PG8_BAR; PG8_MMA(0, 0, At, B0); PG8_MMA(0, 1, At, B1); PG8_BAR; PG8_SCHED;
            PG8_LDA(At, 0, 1); PG8_STAGE(PG8_SB(0, 0), b2, voffB); PG8_STAGE(PG8_SB(0, 1), b2 + hstep, voffB); PG8_STAGE(PG8_SA(0, 0), a2, voffA);
            PG8_WAIT_V(8); PG8_WAIT_L(0); PG8_BAR; PG8_MMA(1, 0, At, B0); PG8_MMA(1, 1, At, B1); PG8_BAR; PG8_SCHED;
            PG8_LDB(B0, 1, 0); PG8_LDB(B1, 1, 1); PG8_SCHED; PG8_LDA(At, 1, 0); PG8_STAGE(PG8_SA(0, 1), a2 + hstep, voffA);
            PG8_WAIT_V(8); PG8_WAIT_L(0); PG8_BAR; PG8_MMA(0, 0, At, B0); PG8_MMA(0, 1, At, B1); PG8_BAR; PG8_SCHED;
            PG8_LDA(At, 1, 1); PG8_STAGE(PG8_SB(1, 0), b3, voffB); PG8_STAGE(PG8_SB(1, 1), b3 + hstep, voffB); PG8_STAGE(PG8_SA(1, 0), a3, voffA);
            PG8_WAIT_V(8); PG8_WAIT_L(0); PG8_BAR; PG8_MMA(1, 0, At, B0); PG8_MMA(1, 1, At, B1); PG8_BAR; PG8_SCHED;
            } else {
            PG8_LDB(B0, 0, 0); PG8_SCHED; PG8_LDA(At, 0, 0); PG8_STAGE(PG8_SA(1, 1), a1 + hstep, voffA);
            PG8_WAIT_L(8); PG8_BAR; PG8_WAIT_L(0); PG8_MMA(0, 0, At, B0); PG8_BAR; PG8_SCHED;
            PG8_LDB(B1, 0, 1); PG8_STAGE(PG8_SB(0, 0), b2, voffB);
            PG8_BAR; PG8_WAIT_L(0); PG8_MMA(0, 1, At, B1); PG8_BAR;
            PG8_LDA(At, 0, 1); PG8_STAGE(PG8_SA(0, 0), a2, voffA);
            PG8_BAR; PG8_WAIT_L(0); PG8_MMA(1, 0, At, B0); PG8_BAR; PG8_SCHED;
            PG8_STAGE(PG8_SB(0, 1), b2 + hstep, voffB);
            PG8_WAIT_V(6); PG8_BAR; PG8_MMA(1, 1, At, B1); PG8_BAR;
            PG8_LDB(B0, 1, 0); PG8_SCHED; PG8_LDA(At, 1, 0); PG8_STAGE(PG8_SA(0, 1), a2 + hstep, voffA);
            PG8_WAIT_L(8); PG8_BAR; PG8_WAIT_L(0); PG8_MMA(0, 0, At, B0); PG8_BAR; PG8_SCHED;
            PG8_LDB(B1, 1, 1); PG8_STAGE(PG8_SB(1, 0), b3, voffB);
            PG8_BAR; PG8_WAIT_L(0); PG8_MMA(0, 1, At, B1); PG8_BAR;
            PG8_LDA(At, 1, 1); PG8_STAGE(PG8_SA(1, 0), a3, voffA);
            PG8_BAR; PG8_WAIT_L(0); PG8_MMA(1, 0, At, B0); PG8_BAR; PG8_SCHED;
            PG8_STAGE(PG8_SB(1, 1), b3 + hstep, voffB);
            PG8_WAIT_V(6); PG8_BAR; PG8_MMA(1, 1, At, B1); PG8_BAR;
            }
        }
        if constexpr (ALIGN_EPI) { if (wr == 0) PG8_BAR; }
        if constexpr (!Epi::AFTER_DRAIN) { E(acc, cur, wr, wc, fr, fq); S.done(cur); }
        const bool zero_ = S.zero_after(cur);
        if (!has_next) break;
        if (zero_)
#pragma unroll
        for (int a = 0; a < 2; ++a)
#pragma unroll
            for (int b = 0; b < 2; ++b)
#pragma unroll
                for (int m = 0; m < 4; ++m)
#pragma unroll
                    for (int n = 0; n < 2; ++n) acc[a][b][m][n] = (f32x4){0.f, 0.f, 0.f, 0.f};
        cur = nxt; cA = nA; cB = nB; ++ui; nt = S.nt(cur);
        if constexpr (ALIGN_EPI) { if (wr == 1) PG8_BAR; }
    }
    PG8_WAIT_V(0);
    if constexpr (!ALIGN_EPI) { if (wr == 0) PG8_BAR; }
    PG8_BAR;
    if constexpr (Epi::AFTER_DRAIN) { E.fused(acc, cur, wr, wc, fr, fq, lds, wid, lane); S.done(cur); }
#undef PG8_SA
#undef PG8_SB
#undef PG8_STAGE
#undef PG8_LDA
#undef PG8_LDB
#undef PG8_MMA
#undef PG8_WAIT_V
#undef PG8_WAIT_L
#undef PG8_BAR
#undef PG8_SCHED
}
}
namespace cg = cooperative_groups;
#define LAS __attribute__((address_space(3)))
typedef unsigned short bf16;
typedef short bf16x8 __attribute__((ext_vector_type(8)));
typedef float f32x4 __attribute__((ext_vector_type(4)));
typedef float f32x16 __attribute__((ext_vector_type(16)));
typedef unsigned u32x4 __attribute__((ext_vector_type(4)));
typedef unsigned u32x2 __attribute__((ext_vector_type(2)));

constexpr int DM = 1024, INC = 10240, GT = 16384, NGROUPS = 3, DEPTH = 2;
constexpr int NTHREADS = 512, NWAVES = 8;
constexpr float RMS_EPS = 1e-6f;
constexpr float QSCALE = 0.125f * 1.4426950408889634f;
constexpr size_t MiB = 1u << 20;
constexpr size_t WS_PCNT = 16384;
constexpr size_t WS_SLOTS = 65536;
constexpr size_t WS_KNMAX = 32768;
constexpr size_t WS_WIN = 2 * MiB;
constexpr size_t WS_WAC = 42 * MiB;
constexpr size_t WS_WB = 46 * MiB;
constexpr size_t WS_WO = 50 * MiB;
constexpr size_t WS_R1 = 54 * MiB;
constexpr size_t WS_ZQKV = 86 * MiB;
constexpr size_t WS_ZA = 182 * MiB;
constexpr size_t WS_ZC = 230 * MiB;
constexpr size_t WS_ZBG = 278 * MiB;
constexpr size_t WS_ZM = 310 * MiB;
constexpr size_t WS_AP = 406 * MiB;
constexpr size_t WS_VP = 438 * MiB;
constexpr size_t WS_END = 470 * MiB;
constexpr int RING_BYTES = 131072, LDS_TAB = RING_BYTES, LDS_BYTES = 147456;

struct Params {
    const float* in[20];
    float* out;
    unsigned char* ws;
    double invrev[32];
    int ph_lo, ph_hi;
};

__device__ __forceinline__ float bf2f(unsigned short b) { return __uint_as_float(((unsigned)b) << 16); }
__device__ __forceinline__ float bflo(unsigned w) { return __uint_as_float(w << 16); }
__device__ __forceinline__ float bfhi(unsigned w) { return __uint_as_float(w & 0xffff0000u); }
__device__ __forceinline__ unsigned pk2(float lo, float hi) { return pg8::cvt_pk_bf16(lo, hi); }
__device__ __forceinline__ unsigned short f2bf(float f) { return (unsigned short)(pk2(f, 0.f) & 0xffffu); }
__device__ __forceinline__ float wave_sum(float v) {
#pragma unroll
    for (int o = 1; o < 64; o <<= 1) v += __shfl_xor(v, o);
    return v;
}
__device__ __forceinline__ float sigmoidf_(float x) { return __builtin_amdgcn_rcpf(1.0f + __expf(-x)); }
__device__ __forceinline__ float siluf_(float x) { return x * __builtin_amdgcn_rcpf(1.0f + __expf(-x)); }
__device__ __forceinline__ int crow(int r, int hi) { return (r & 3) + 8 * (r >> 2) + 4 * hi; }

struct EpiZ {
    static constexpr bool PERM = true, AFTER_DRAIN = false;
    bf16 *Qp, *Kp, *Vp, *Za, *Zc, *Zbg, *Zm; const LAS double* tab; int seqlen; unsigned* knmax;
    __device__ __forceinline__ void operator()(const pg8::f32x4 (&acc)[2][2][4][2], const pg8::Unit& u, int wr, int wc, int fr, int fq) const {
        const int pn = u.pn;
        const int row0 = u.pm * 256 + wr * 64 + fr;
        if (pn >= 6 && pn < 14) {
            const int t = pn - 6, isk = t >> 2, vh = 4 * (t & 3) + wc;
            unsigned iv[8];
#pragma unroll
            for (int e = 0; e < 8; ++e) iv[e] = (unsigned)(tab[8 * fq + e] * 4294967296.0);
            const float sc = isk ? 1.0f : QSCALE;
            float kmx = 0.f;
#pragma unroll
            for (int ai = 0; ai < 2; ++ai)
#pragma unroll
                for (int m = 0; m < 4; ++m) {
                    const int tok = row0 + ai * 128 + m * 16;
                    const unsigned pos = (unsigned)(tok & (seqlen - 1));
                    float o1[8], o2[8];
#pragma unroll
                    for (int e = 0; e < 8; ++e) {
                        const float frv = (float)(pos * iv[e]) * 2.3283064365386963e-10f;
                        const float sn = __builtin_amdgcn_sinf(frv), cs = __builtin_amdgcn_cosf(frv);
                        const float x1 = acc[ai][0][m][e >> 2][e & 3], x2 = acc[ai][1][m][e >> 2][e & 3];
                        o1[e] = (x1 * cs - x2 * sn) * sc; o2[e] = (x2 * cs + x1 * sn) * sc;
                    }
                    if (isk) { float n2 = 0.f;
#pragma unroll
                        for (int e = 0; e < 8; ++e) n2 += o1[e] * o1[e] + o2[e] * o2[e];
                        n2 += __shfl_xor(n2, 16); n2 += __shfl_xor(n2, 32);
                        kmx = fmaxf(kmx, n2); }
                    u32x4 w1, w2;
                    w1.x = pk2(o1[0], o1[1]); w1.y = pk2(o1[2], o1[3]); w1.z = pk2(o1[4], o1[5]); w1.w = pk2(o1[6], o1[7]);
                    w2.x = pk2(o2[0], o2[1]); w2.y = pk2(o2[2], o2[3]); w2.z = pk2(o2[4], o2[5]); w2.w = pk2(o2[6], o2[7]);
                    if (!isk) { bf16* qd = Qp + (size_t)tok * 1024 + vh * 64 + 8 * fq; *(u32x4*)qd = w1; *(u32x4*)(qd + 32) = w2; }
                    else { bf16* kd = Kp + (size_t)(vh * 256 + (tok >> 6)) * 4096 + (tok & 63) * 8; *(u32x4*)(kd + fq * 512) = w1; *(u32x4*)(kd + (fq + 4) * 512) = w2; }
                }
            if (isk) { kmx = fmaxf(kmx, __shfl_xor(kmx, 1)); kmx = fmaxf(kmx, __shfl_xor(kmx, 2)); kmx = fmaxf(kmx, __shfl_xor(kmx, 4)); kmx = fmaxf(kmx, __shfl_xor(kmx, 8));
                if (fr == 0 && fq == 0) __hip_atomic_fetch_max(knmax + ((u.pm * 256) / seqlen) * 16 + vh, __float_as_uint(kmx), __ATOMIC_RELAXED, __HIP_MEMORY_SCOPE_AGENT); }
            return;
        }
        if (pn >= 14 && pn < 18) {
            const int t = pn - 14;
            const int hi_ = (fr >> 2) & 1, j_ = (fr & 3) + 4 * (fr >> 3);
#pragma unroll
            for (int ai = 0; ai < 2; ++ai)
#pragma unroll
                for (int m = 0; m < 4; ++m) {
                    const int gt = 4 * u.pm + 2 * ai + wr;
#pragma unroll
                    for (int bj = 0; bj < 2; ++bj) {
                        bf16* vd = Vp + (size_t)((2 * t + bj) * 256 + gt) * 8192 + ((wc * 4 + m) * 2 + hi_) * 256 + (8 * fq) * 8 + j_;
                        const pg8::f32x4 v0 = acc[ai][bj][m][0], v1 = acc[ai][bj][m][1];
                        vd[0] = f2bf(v0[0]); vd[8] = f2bf(v0[1]); vd[16] = f2bf(v0[2]); vd[24] = f2bf(v0[3]);
                        vd[32] = f2bf(v1[0]); vd[40] = f2bf(v1[1]); vd[48] = f2bf(v1[2]); vd[56] = f2bf(v1[3]);
                    }
                }
            return;
        }
        if (pn < 4) {
#pragma unroll
            for (int ai = 0; ai < 2; ++ai)
#pragma unroll
                for (int m = 0; m < 4; ++m) {
                    const pg8::f32x4 u0 = acc[ai][0][m][0], u1 = acc[ai][0][m][1], g0 = acc[ai][1][m][0], g1 = acc[ai][1][m][1];
                    u32x4 w;
                    w.x = pk2(u0[0] * sigmoidf_(g0[0]), u0[1] * sigmoidf_(g0[1])); w.y = pk2(u0[2] * sigmoidf_(g0[2]), u0[3] * sigmoidf_(g0[3]));
                    w.z = pk2(u1[0] * sigmoidf_(g1[0]), u1[1] * sigmoidf_(g1[1])); w.w = pk2(u1[2] * sigmoidf_(g1[2]), u1[3] * sigmoidf_(g1[3]));
                    *(u32x4*)(Za + (size_t)(row0 + ai * 128 + m * 16) * 1024 + pn * 128 + wc * 32 + 8 * fq) = w;
                }
            return;
        }
        if (pn >= 22 && pn < 26) {
#pragma unroll
            for (int ai = 0; ai < 2; ++ai)
#pragma unroll
                for (int m = 0; m < 4; ++m) {
                    const pg8::f32x4 u0 = acc[ai][0][m][0], u1 = acc[ai][0][m][1], g0 = acc[ai][1][m][0], g1 = acc[ai][1][m][1];
                    u32x4 w;
                    w.x = pk2(u0[0] * siluf_(g0[0]), u0[1] * siluf_(g0[1])); w.y = pk2(u0[2] * siluf_(g0[2]), u0[3] * siluf_(g0[3]));
                    w.z = pk2(u1[0] * siluf_(g1[0]), u1[1] * siluf_(g1[1])); w.w = pk2(u1[2] * siluf_(g1[2]), u1[3] * siluf_(g1[3]));
                    *(u32x4*)(Zc + (size_t)(row0 + ai * 128 + m * 16) * 1024 + (pn - 22) * 128 + wc * 32 + 8 * fq) = w;
                }
            return;
        }
        bf16* base; int ld, ct;
        if (pn < 6) { base = Za + 512; ld = 1024; ct = pn - 4; }
        else if (pn < 22) { base = Zbg; ld = 1024; ct = pn - 18; }
        else if (pn < 28) { base = Zc + 512; ld = 1024; ct = pn - 26; }
        else { base = Zm; ld = 3072; ct = pn - 28; }
        const int col0 = ct * 256 + wc * 32 + 8 * fq;
#pragma unroll
        for (int ai = 0; ai < 2; ++ai)
#pragma unroll
            for (int m = 0; m < 4; ++m) {
                bf16* rowp = base + (size_t)(row0 + ai * 128 + m * 16) * ld + col0;
#pragma unroll
                for (int bj = 0; bj < 2; ++bj) {
                    const pg8::f32x4 v0 = acc[ai][bj][m][0], v1 = acc[ai][bj][m][1];
                    u32x4 w; w.x = pk2(v0[0], v0[1]); w.y = pk2(v0[2], v0[3]); w.z = pk2(v1[0], v1[1]); w.w = pk2(v1[2], v1[3]);
                    *(u32x4*)(rowp + bj * 128) = w;
                }
            }
    }
};
__device__ __forceinline__ int wperm_qk(int n) {
    if (n < 1024) { const int half = n >> 9, c = n & 511; return 256 * (c >> 7) + 128 * half + (c & 127); }
    if (n >= 5632 && n < 7168) {
        if (n < 6144) { const int c = n - 5632; return 5632 + 256 * (c >> 7) + (c & 127); }
        if (n >= 6656) { const int c = n - 6656; return 5632 + 256 * (c >> 7) + 128 + (c & 127); }
        return 6656 + (n - 6144);
    }
    if (n < 1536 || n >= 3584) return n;
    const int o = (n - 1536) & 255, t = (n - 1536) >> 8, hm = o >> 6, half = (o >> 5) & 1, dd = o & 31;
    return 1536 + 256 * t + 128 * half + 32 * hm + dd;
}
__device__ __forceinline__ float eneg_(float x) { return fminf(__expf(-x), 1e30f); }
struct SegOrder {
    pg8::StaticOrder so; const bf16 *AC, *B, *WAC, *WB;
    __device__ bool next(int i, pg8::Unit& u) const { const bool ok = so.next(i / 3, u); u.seg = i % 3; return ok; }
    __device__ __forceinline__ const char* aptr(const pg8::Unit& u, size_t tstep) const { return (const char*)(u.seg == 1 ? B : AC) + (size_t)u.pm * tstep + (u.seg == 2 ? 1024 : 0); }
    __device__ __forceinline__ const char* bptr(const pg8::Unit& u, size_t tstep) const { return (const char*)(u.seg == 1 ? WB : WAC) + (size_t)u.pn * tstep + (u.seg == 2 ? 1024 : 0); }
    __device__ __forceinline__ int nt(const pg8::Unit& u) const { return u.seg == 1 ? 16 : 8; }
    __device__ __forceinline__ bool zero_after(const pg8::Unit& u) const { return u.seg == 2; }
    __device__ __forceinline__ void a_ready(const pg8::Unit&) const {}
    __device__ __forceinline__ void done(const pg8::Unit&) const {}
};
struct EpiGate3 {
    static constexpr bool PERM = true, AFTER_DRAIN = false;
    const bf16* Zm; bf16* Yb;
    __device__ __forceinline__ void operator()(pg8::f32x4 (&acc)[2][2][4][2], const pg8::Unit& u, int wr, int wc, int fr, int fq) const {
        const int row0 = u.pm * 256 + wr * 64 + fr, col0 = u.pn * 256 + wc * 32 + 8 * fq;
        const int seg = u.seg;
        const int jn = seg, jd = seg == 2 ? 2 : seg + 1;
#pragma unroll
        for (int ai = 0; ai < 2; ++ai)
#pragma unroll
            for (int m = 0; m < 4; ++m) {
                const size_t row = (size_t)(row0 + ai * 128 + m * 16);
#pragma unroll
                for (int bj = 0; bj < 2; ++bj) {
                    const int col = col0 + bj * 128;
                    const u32x4 g1 = *(const u32x4*)(Zm + row * 3072 + jn * 1024 + col);
                    const u32x4 g2 = *(const u32x4*)(Zm + row * 3072 + jd * 1024 + col);
                    float e1[8], e2[8];
                    e1[0] = eneg_(bflo(g1.x)); e1[1] = eneg_(bfhi(g1.x)); e1[2] = eneg_(bflo(g1.y)); e1[3] = eneg_(bfhi(g1.y));
                    e1[4] = eneg_(bflo(g1.z)); e1[5] = eneg_(bfhi(g1.z)); e1[6] = eneg_(bflo(g1.w)); e1[7] = eneg_(bfhi(g1.w));
                    e2[0] = eneg_(bflo(g2.x)); e2[1] = eneg_(bfhi(g2.x)); e2[2] = eneg_(bflo(g2.y)); e2[3] = eneg_(bfhi(g2.y));
                    e2[4] = eneg_(bflo(g2.z)); e2[5] = eneg_(bfhi(g2.z)); e2[6] = eneg_(bflo(g2.w)); e2[7] = eneg_(bfhi(g2.w));
                    float f[8];
#pragma unroll
                    for (int i = 0; i < 8; ++i) f[i] = (seg == 2 ? 1.0f : 1.0f + e2[i]) * __builtin_amdgcn_rcpf(1.0f + e1[i]);
                    pg8::f32x4& a0 = acc[ai][bj][m][0]; pg8::f32x4& a1 = acc[ai][bj][m][1];
                    a0[0] *= f[0]; a0[1] *= f[1]; a0[2] *= f[2]; a0[3] *= f[3]; a1[0] *= f[4]; a1[1] *= f[5]; a1[2] *= f[6]; a1[3] *= f[7];
                    if (seg == 2) { u32x4 w; w.x = pk2(a0[0], a0[1]); w.y = pk2(a0[2], a0[3]); w.z = pk2(a1[0], a1[1]); w.w = pk2(a1[2], a1[3]);
                                    *(u32x4*)(Yb + row * 1024 + col) = w; }
                }
                asm volatile("" ::: "memory");
            }
    }
};
struct EpiRes {
    static constexpr bool PERM = true, AFTER_DRAIN = false;
    const float* res; float* out;
    __device__ __forceinline__ void operator()(const pg8::f32x4 (&acc)[2][2][4][2], const pg8::Unit& u, int wr, int wc, int fr, int fq) const {
        const int row0 = u.pm * 256 + wr * 64 + fr, col0 = u.pn * 256 + wc * 32 + 8 * fq;
#pragma unroll
        for (int ai = 0; ai < 2; ++ai)
#pragma unroll
            for (int m = 0; m < 4; ++m) {
                const size_t row = (size_t)(row0 + ai * 128 + m * 16);
#pragma unroll
                for (int bj = 0; bj < 2; ++bj) {
                    const size_t off = row * 1024 + col0 + bj * 128;
                    const f32x4 r0 = *(const f32x4*)(res + off), r1 = *(const f32x4*)(res + off + 4);
                    const pg8::f32x4 a0 = acc[ai][bj][m][0], a1 = acc[ai][bj][m][1];
                    f32x4 o0, o1;
                    o0[0] = r0[0] + a0[0]; o0[1] = r0[1] + a0[1]; o0[2] = r0[2] + a0[2]; o0[3] = r0[3] + a0[3];
                    o1[0] = r1[0] + a1[0]; o1[1] = r1[1] + a1[1]; o1[2] = r1[2] + a1[2]; o1[3] = r1[3] + a1[3];
                    *(f32x4*)(out + off) = o0; *(f32x4*)(out + off + 4) = o1;
                }
            }
    }
};

struct EpiResNorm {
    static constexpr bool PERM = true, AFTER_DRAIN = true;
    const float* res; float* out; bf16* xn; const float* g; unsigned* slots; unsigned* cnt;
    __device__ __forceinline__ void fused(pg8::f32x4 (&acc)[2][2][4][2], const pg8::Unit& u, int wr, int wc, int fr, int fq, PG8_LAS unsigned char* lds, int wid, int lane) const {
        LAS float* P = (LAS float*)lds;
        LAS float* S = (LAS float*)(lds + 4096);
        const int rl0 = wr * 64 + fr, col0 = u.pn * 256 + wc * 32 + 8 * fq;
#pragma unroll
        for (int ai = 0; ai < 2; ++ai)
#pragma unroll
            for (int m = 0; m < 4; ++m) {
                const int rl = rl0 + ai * 128 + m * 16; const size_t row = (size_t)(u.pm * 256 + rl);
                float s = 0.f;
#pragma unroll
                for (int bj = 0; bj < 2; ++bj) {
                    const size_t off = row * 1024 + col0 + bj * 128;
                    const f32x4 r0 = *(const f32x4*)(res + off), r1 = *(const f32x4*)(res + off + 4);
                    pg8::f32x4& a0 = acc[ai][bj][m][0]; pg8::f32x4& a1 = acc[ai][bj][m][1];
                    a0[0] += r0[0]; a0[1] += r0[1]; a0[2] += r0[2]; a0[3] += r0[3]; a1[0] += r1[0]; a1[1] += r1[1]; a1[2] += r1[2]; a1[3] += r1[3];
                    s += ((a0[0] * a0[0] + a0[1] * a0[1]) + (a0[2] * a0[2] + a0[3] * a0[3])) + ((a1[0] * a1[0] + a1[1] * a1[1]) + (a1[2] * a1[2] + a1[3] * a1[3]));
                }
                s += __shfl_xor(s, 16); s += __shfl_xor(s, 32);
                if (fq == 0) P[rl * 4 + wc] = s;
                if (m & 1) asm volatile("" ::: "memory");
            }
        asm volatile("s_waitcnt lgkmcnt(0)" ::: "memory"); __builtin_amdgcn_s_barrier(); asm volatile("" ::: "memory");
        if (wid < 4) {
            const int rl = wid * 64 + lane;
            const float t = (P[rl * 4 + 0] + P[rl * 4 + 1]) + (P[rl * 4 + 2] + P[rl * 4 + 3]);
            __hip_atomic_store(slots + ((size_t)(u.pm * 256 + rl) * 4 + u.pn), __float_as_uint(t), __ATOMIC_RELAXED, __HIP_MEMORY_SCOPE_AGENT);
            asm volatile("s_waitcnt vmcnt(0)" ::: "memory");
            if (lane == 0) __hip_atomic_fetch_add(cnt + u.pm, 1u, __ATOMIC_RELAXED, __HIP_MEMORY_SCOPE_AGENT);
        }
        if (wid == 0) {
            unsigned sp = 0;
            while ((unsigned)__builtin_amdgcn_readfirstlane(__hip_atomic_load(cnt + u.pm, __ATOMIC_RELAXED, __HIP_MEMORY_SCOPE_AGENT)) < 16u) { __builtin_amdgcn_s_sleep(2); if (++sp > (1u << 22)) break; }
            __builtin_amdgcn_fence(__ATOMIC_ACQUIRE, "agent");
        }
        asm volatile("s_waitcnt vmcnt(0) lgkmcnt(0)" ::: "memory"); __builtin_amdgcn_s_barrier(); asm volatile("" ::: "memory");
        if (wid < 4) {
            const int rl = wid * 64 + lane; const unsigned* sl = slots + (size_t)(u.pm * 256 + rl) * 4;
            const float t = (__uint_as_float(__hip_atomic_load(sl + 0, __ATOMIC_RELAXED, __HIP_MEMORY_SCOPE_AGENT)) + __uint_as_float(__hip_atomic_load(sl + 1, __ATOMIC_RELAXED, __HIP_MEMORY_SCOPE_AGENT)))
                          + (__uint_as_float(__hip_atomic_load(sl + 2, __ATOMIC_RELAXED, __HIP_MEMORY_SCOPE_AGENT)) + __uint_as_float(__hip_atomic_load(sl + 3, __ATOMIC_RELAXED, __HIP_MEMORY_SCOPE_AGENT)));
            S[rl] = rsqrtf(t * (1.0f / DM) + RMS_EPS);
        }
        asm volatile("s_waitcnt lgkmcnt(0)" ::: "memory"); __builtin_amdgcn_s_barrier(); asm volatile("" ::: "memory");
        f32x4 gg[2][2];
#pragma unroll
        for (int bj = 0; bj < 2; ++bj) { gg[bj][0] = *(const f32x4*)(g + col0 + bj * 128); gg[bj][1] = *(const f32x4*)(g + col0 + bj * 128 + 4); }
#pragma unroll
        for (int ai = 0; ai < 2; ++ai)
#pragma unroll
            for (int m = 0; m < 4; ++m) {
                const int rl = rl0 + ai * 128 + m * 16; const size_t row = (size_t)(u.pm * 256 + rl);
                const float rs = S[rl];
#pragma unroll
                for (int bj = 0; bj < 2; ++bj) {
                    const size_t off = row * 1024 + col0 + bj * 128;
                    const pg8::f32x4 a0 = acc[ai][bj][m][0], a1 = acc[ai][bj][m][1];
                    f32x4 n0, n1;
                    n0[0] = a0[0] * rs * gg[bj][0][0]; n0[1] = a0[1] * rs * gg[bj][0][1]; n0[2] = a0[2] * rs * gg[bj][0][2]; n0[3] = a0[3] * rs * gg[bj][0][3];
                    n1[0] = a1[0] * rs * gg[bj][1][0]; n1[1] = a1[1] * rs * gg[bj][1][1]; n1[2] = a1[2] * rs * gg[bj][1][2]; n1[3] = a1[3] * rs * gg[bj][1][3];
                    if (xn) { f32x4 x0, x1; x0[0] = a0[0]; x0[1] = a0[1]; x0[2] = a0[2]; x0[3] = a0[3]; x1[0] = a1[0]; x1[1] = a1[1]; x1[2] = a1[2]; x1[3] = a1[3];
                        *(f32x4*)(out + off) = x0; *(f32x4*)(out + off + 4) = x1;
                        u32x4 w; w.x = pk2(n0[0], n0[1]); w.y = pk2(n0[2], n0[3]); w.z = pk2(n1[0], n1[1]); w.w = pk2(n1[2], n1[3]); *(u32x4*)(xn + off) = w; }
                    else { *(f32x4*)(out + off) = n0; *(f32x4*)(out + off + 4) = n1; }
                }
                if (m & 1) asm volatile("" ::: "memory");
            }
    }
};
struct Ctx {
    LAS unsigned char* lds;
    int tid, lane, wave, G, b;
};

template <bool QKPERM = false> __device__ __forceinline__ void transpose_item(const float* W, int K, int N, bf16* WT, LAS float* scr, int item, int lane, int ld) {
    const int nblk = N / 32, kb = item / nblk, nb = item % nblk, k0 = 64 * kb, n0 = 32 * nb;
#pragma unroll 8
    for (int i = 0; i < 32; ++i) { const int kk = 2 * i + (lane >> 5); scr[kk * 33 + (lane & 31)] = W[(size_t)(k0 + kk) * N + n0 + (lane & 31)]; }
    asm volatile("s_waitcnt lgkmcnt(0)" ::: "memory");
    const int c = lane & 7;
    float tv[4][8];
#pragma unroll
    for (int j = 0; j < 4; ++j) { const LAS float* s = scr + (8 * c) * 33 + (lane >> 3) + 8 * j;
#pragma unroll
        for (int e = 0; e < 8; ++e) tv[j][e] = s[e * 33]; }
    asm volatile("s_waitcnt lgkmcnt(0)" ::: "memory");
#pragma unroll
    for (int j = 0; j < 4; ++j) { const int n = (lane >> 3) + 8 * j;
        u32x4 o; o.x = pk2(tv[j][0], tv[j][1]); o.y = pk2(tv[j][2], tv[j][3]); o.z = pk2(tv[j][4], tv[j][5]); o.w = pk2(tv[j][6], tv[j][7]);
        *(u32x4*)(WT + (size_t)(QKPERM ? wperm_qk(n0 + n) : (n0 + n)) * ld + k0 + 8 * c) = o; }
    asm volatile("s_waitcnt lgkmcnt(0)" ::: "memory");
}
__device__ __forceinline__ void phase_weights(const Ctx& C, const Params& p) {
    LAS float* scr = (LAS float*)(C.lds + C.wave * 16384);
    const int gw = C.b * NWAVES + C.wave, NGW = C.G * NWAVES;
    constexpr int I_IN = 16 * 320, I_A = 8 * 32, I_B = 16 * 32, I_C = 8 * 32, I_O = 16 * 32, I_L = I_IN + I_A + I_B + I_C + I_O;
    for (int it = gw; it < DEPTH * I_L; it += NGW) {
        const int l = it / I_L; int r = it % I_L;
        if (r < I_IN) { transpose_item<true>(p.in[3] + (size_t)l * 1024 * INC, 1024, INC, (bf16*)(p.ws + WS_WIN) + (size_t)l * INC * 1024, scr, r, C.lane, 1024); continue; } r -= I_IN;
        if (r < I_A) { transpose_item(p.in[7] + (size_t)l * 512 * 1024, 512, 1024, (bf16*)(p.ws + WS_WAC) + (size_t)l * 1024 * 1024, scr, r, C.lane, 1024); continue; } r -= I_A;
        if (r < I_B) { transpose_item(p.in[13] + (size_t)l * 1024 * 1024, 1024, 1024, (bf16*)(p.ws + WS_WB) + (size_t)l * 1024 * 1024, scr, r, C.lane, 1024); continue; } r -= I_B;
        if (r < I_C) { transpose_item(p.in[17] + (size_t)l * 512 * 1024, 512, 1024, (bf16*)(p.ws + WS_WAC) + (size_t)l * 1024 * 1024 + 512, scr, r, C.lane, 1024); continue; } r -= I_C;
        transpose_item(p.in[18] + (size_t)l * 1024 * 1024, 1024, 1024, (bf16*)(p.ws + WS_WO) + (size_t)l * 1024 * 1024, scr, r, C.lane, 1024);
    }
}

__device__ __forceinline__ void phase_norm_in(const Ctx& C, const float* x, const float* g, bf16* XN, unsigned* knmax) {
    const int gw = C.b * NWAVES + C.wave, NGW = C.G * NWAVES;
    if (C.b == 0 && C.tid < 128) knmax[C.tid] = 0u;
    f32x4 gg[4];
#pragma unroll
    for (int j = 0; j < 4; ++j) gg[j] = ((const f32x4*)g)[C.lane + 64 * j];
#pragma unroll 2
    for (int m = gw; m < GT; m += NGW) {
        const f32x4* xr = (const f32x4*)(x + (size_t)m * DM) + C.lane;
        f32x4 v[4]; float ss = 0.f;
#pragma unroll
        for (int j = 0; j < 4; ++j) { v[j] = xr[64 * j]; ss += (v[j][0] * v[j][0] + v[j][1] * v[j][1]) + (v[j][2] * v[j][2] + v[j][3] * v[j][3]); }
        const float rstd = rsqrtf(wave_sum(ss) * (1.0f / DM) + RMS_EPS);
        u32x2* o8 = (u32x2*)(XN + (size_t)m * DM) + C.lane;
#pragma unroll
        for (int j = 0; j < 4; ++j) { u32x2 w; w.x = pk2(v[j][0] * rstd * gg[j][0], v[j][1] * rstd * gg[j][1]); w.y = pk2(v[j][2] * rstd * gg[j][2], v[j][3] * rstd * gg[j][3]); o8[64 * j] = w; }
    }
}
__device__ __forceinline__ void phase_norm_final(const Ctx& C, float* x, const float* g) {
    const int gw = C.b * NWAVES + C.wave, NGW = C.G * NWAVES;
    f32x4 gg[4];
#pragma unroll
    for (int j = 0; j < 4; ++j) gg[j] = ((const f32x4*)g)[C.lane + 64 * j];
#pragma unroll 2
    for (int m = gw; m < GT; m += NGW) {
        f32x4* xr = (f32x4*)(x + (size_t)m * DM) + C.lane;
        f32x4 v[4]; float ss = 0.f;
#pragma unroll
        for (int j = 0; j < 4; ++j) { v[j] = xr[64 * j]; ss += (v[j][0] * v[j][0] + v[j][1] * v[j][1]) + (v[j][2] * v[j][2] + v[j][3] * v[j][3]); }
        const float rstd = rsqrtf(wave_sum(ss) * (1.0f / DM) + RMS_EPS);
#pragma unroll
        for (int j = 0; j < 4; ++j) { f32x4 o; o[0] = v[j][0] * rstd * gg[j][0]; o[1] = v[j][1] * rstd * gg[j][1]; o[2] = v[j][2] * rstd * gg[j][2]; o[3] = v[j][3] * rstd * gg[j][3]; xr[64 * j] = o; }
    }
}

__device__ __forceinline__ void phase_qkv_prep(const Ctx& C, bf16* Zqkv, bf16* Kp, bf16* Vp, int seqlen) {
    const LAS double* tab = (const LAS double*)(C.lds + LDS_TAB);
    for (int gt = C.b; gt < GT / 64; gt += C.G) {
        const int pos0 = (gt * 64) % seqlen;
#pragma unroll 2
        for (int it = 0; it < 16; ++it) {
            const int e = C.tid + NTHREADS * it;
            const int c8 = e & 3, vh = (e >> 2) & 15, qk = (e >> 6) & 1, tok = e >> 7;
            bf16* src = Zqkv + (size_t)(gt * 64 + tok) * 3072 + qk * 1024 + vh * 64;
            const u32x4 x1 = *(const u32x4*)(src + 8 * c8), x2 = *(const u32x4*)(src + 32 + 8 * c8);
            const double pos = (double)(pos0 + tok);
            float a1[8], a2[8];
            a1[0] = bflo(x1.x); a1[1] = bfhi(x1.x); a1[2] = bflo(x1.y); a1[3] = bfhi(x1.y); a1[4] = bflo(x1.z); a1[5] = bfhi(x1.z); a1[6] = bflo(x1.w); a1[7] = bfhi(x1.w);
            a2[0] = bflo(x2.x); a2[1] = bfhi(x2.x); a2[2] = bflo(x2.y); a2[3] = bfhi(x2.y); a2[4] = bflo(x2.z); a2[5] = bfhi(x2.z); a2[6] = bflo(x2.w); a2[7] = bfhi(x2.w);
            const float sc = qk == 0 ? QSCALE : 1.0f;
            float o1[8], o2[8];
#pragma unroll
            for (int jj = 0; jj < 8; ++jj) {
                double rev = pos * tab[8 * c8 + jj]; rev -= floor(rev);
                const float fr = (float)rev;
                const float sn = __builtin_amdgcn_sinf(fr), cs = __builtin_amdgcn_cosf(fr);
                o1[jj] = (a1[jj] * cs - a2[jj] * sn) * sc; o2[jj] = (a2[jj] * cs + a1[jj] * sn) * sc;
            }
            u32x4 w1, w2;
            w1.x = pk2(o1[0], o1[1]); w1.y = pk2(o1[2], o1[3]); w1.z = pk2(o1[4], o1[5]); w1.w = pk2(o1[6], o1[7]);
            w2.x = pk2(o2[0], o2[1]); w2.y = pk2(o2[2], o2[3]); w2.z = pk2(o2[4], o2[5]); w2.w = pk2(o2[6], o2[7]);
            if (qk == 0) { *(u32x4*)(src + 8 * c8) = w1; *(u32x4*)(src + 32 + 8 * c8) = w2; }
            else { bf16* kb = Kp + (size_t)(vh * 256 + gt) * 4096 + tok * 8;
                   *(u32x4*)(kb + c8 * 512) = w1; *(u32x4*)(kb + (c8 + 4) * 512) = w2; }
        }
#pragma unroll 4
        for (int it = 0; it < 16; ++it) {
            const int e = C.tid + NTHREADS * it;
            const int n = e & 31, hi = (e >> 5) & 1, ks = (e >> 6) & 3, db = (e >> 8) & 3, h = (e >> 10) & 7;
            const bf16* src = Zqkv + (size_t)(gt * 64 + 16 * ks + 4 * hi) * 3072 + 2048 + h * 128 + 32 * db + n;
            unsigned short v[8];
#pragma unroll
            for (int j = 0; j < 8; ++j) v[j] = src[(size_t)((j & 3) + 8 * (j >> 2)) * 3072];
            u32x4 w; w.x = v[0] | ((unsigned)v[1] << 16); w.y = v[2] | ((unsigned)v[3] << 16); w.z = v[4] | ((unsigned)v[5] << 16); w.w = v[6] | ((unsigned)v[7] << 16);
            *(u32x4*)(Vp + (size_t)(h * 256 + gt) * 8192 + ((db * 4 + ks) * 2 + hi) * 256 + n * 8) = w;
        }
    }
}

__device__ __forceinline__ void phase_conv(const Ctx& C, const bf16* Za, bf16* Ap, const float* cw, const float* cb, const float* cng, int seqlen) {
    LAS float* A = (LAS float*)C.lds;
    const int c = C.tid;
    float w[31];
#pragma unroll
    for (int k = 0; k < 31; ++k) w[k] = cw[k * 512 + c];
    const float bias = cb[c];
    const f32x4 gn0 = *(const f32x4*)(cng + C.lane * 8), gn1 = *(const f32x4*)(cng + C.lane * 8 + 4);
#define CONV_LOAD(TT) do { const int t0_ = (TT) * 32, ss_ = (t0_ / seqlen) * seqlen, se_ = ss_ + seqlen; \
        _Pragma("unroll") for (int ii = 0; ii < 8; ++ii) { const int i = C.wave + 8 * ii, tok = t0_ - 15 + i; \
            xu[ii] = u32x4{0u, 0u, 0u, 0u}; \
            if (i < 62 && tok >= ss_ && tok < se_) xu[ii] = *(const u32x4*)(Za + (size_t)tok * 1024 + C.lane * 8); } } while (0)
    u32x4 xu[8];
    if (C.b < GT / 32) CONV_LOAD(C.b);
    for (int tt = C.b; tt < GT / 32; tt += C.G) {
        const int t0 = tt * 32;
#pragma unroll
        for (int ii = 0; ii < 8; ++ii) { const int i = C.wave + 8 * ii;
            if (i < 62) { f32x4 a0, a1;
                a0[0] = bflo(xu[ii].x); a0[1] = bfhi(xu[ii].x); a0[2] = bflo(xu[ii].y); a0[3] = bfhi(xu[ii].y);
                a1[0] = bflo(xu[ii].z); a1[1] = bfhi(xu[ii].z); a1[2] = bflo(xu[ii].w); a1[3] = bfhi(xu[ii].w);
                *(LAS f32x4*)(A + i * 512 + C.lane * 8) = a0; *(LAS f32x4*)(A + i * 512 + C.lane * 8 + 4) = a1; } }
        if (tt + C.G < GT / 32) CONV_LOAD(tt + C.G);
        u32x4 gt4[4];
#pragma unroll
        for (int tq = 0; tq < 4; ++tq) gt4[tq] = *(const u32x4*)(Za + (size_t)(t0 + C.wave * 4 + tq) * 1024 + 512 + C.lane * 8);
        __syncthreads();
#pragma unroll 1
        for (int t = 0; t < 32; t += 4) {
            float a0 = bias, a1 = bias, a2 = bias, a3 = bias;
#pragma unroll
            for (int k = 0; k < 34; ++k) {
                const float x = A[(t + k) * 512 + c];
                if (k < 31) a0 += w[k] * x;
                if (k >= 1 && k < 32) a1 += w[k - 1] * x;
                if (k >= 2 && k < 33) a2 += w[k - 2] * x;
                if (k >= 3) a3 += w[k - 3] * x;
            }
            A[t * 512 + c] = a0; A[(t + 1) * 512 + c] = a1; A[(t + 2) * 512 + c] = a2; A[(t + 3) * 512 + c] = a3;
        }
        __syncthreads();
#pragma unroll
        for (int tq = 0; tq < 4; ++tq) {
            const int t = C.wave * 4 + tq, tok = t0 + t;
            const f32x4 y0 = *(const LAS f32x4*)(A + t * 512 + C.lane * 8), y1 = *(const LAS f32x4*)(A + t * 512 + C.lane * 8 + 4);
            float sq = (y0[0] * y0[0] + y0[1] * y0[1]) + (y0[2] * y0[2] + y0[3] * y0[3]) + (y1[0] * y1[0] + y1[1] * y1[1]) + (y1[2] * y1[2] + y1[3] * y1[3]);
            const float rstd = rsqrtf(wave_sum(sq) * (1.0f / 512) + RMS_EPS);
            const u32x4 g = gt4[tq];
            u32x4 o;
            o.x = pk2(siluf_(y0[0] * rstd * gn0[0]) * siluf_(bflo(g.x)), siluf_(y0[1] * rstd * gn0[1]) * siluf_(bfhi(g.x)));
            o.y = pk2(siluf_(y0[2] * rstd * gn0[2]) * siluf_(bflo(g.y)), siluf_(y0[3] * rstd * gn0[3]) * siluf_(bfhi(g.y)));
            o.z = pk2(siluf_(y1[0] * rstd * gn1[0]) * siluf_(bflo(g.z)), siluf_(y1[1] * rstd * gn1[1]) * siluf_(bfhi(g.z)));
            o.w = pk2(siluf_(y1[2] * rstd * gn1[2]) * siluf_(bflo(g.w)), siluf_(y1[3] * rstd * gn1[3]) * siluf_(bfhi(g.w)));
            *(u32x4*)(Ap + (size_t)tok * 1024 + C.lane * 8) = o;
        }
        __syncthreads();
    }
}

#undef CONV_LOAD
__device__ __forceinline__ void phase_sgu(const Ctx& C, const bf16* Zc, bf16* Cp, const float* sng, const float* sw, const float* sb) {
    constexpr int QS = 136;
    LAS bf16* cvT = (LAS bf16*)C.lds;
    LAS float* rs = (LAS float*)(C.lds + 256 * QS * 2);
    const int r32 = C.lane & 31, hi = C.lane >> 5;
    for (int item = C.b; item < 2 * (GT / 128); item += C.G) {
        const int ch = item >> 1, gp = item & 1;
        const int tokbase = ch * 128;
        {
            u32x4 x[16];
#pragma unroll
            for (int qq = 0; qq < 16; ++qq) x[qq] = *(const u32x4*)(Zc + (size_t)(tokbase + C.wave * 16 + qq) * 1024 + 512 + C.lane * 8);
#pragma unroll
            for (int qq = 0; qq < 16; ++qq) {
                float s = bflo(x[qq].x) * bflo(x[qq].x) + bfhi(x[qq].x) * bfhi(x[qq].x) + bflo(x[qq].y) * bflo(x[qq].y) + bfhi(x[qq].y) * bfhi(x[qq].y)
                        + bflo(x[qq].z) * bflo(x[qq].z) + bfhi(x[qq].z) * bfhi(x[qq].z) + bflo(x[qq].w) * bflo(x[qq].w) + bfhi(x[qq].w) * bfhi(x[qq].w);
                s = wave_sum(s);
                if (C.lane == 0) rs[C.wave * 16 + qq] = rsqrtf(s * (1.0f / 512) + RMS_EPS);
            }
        }
        __syncthreads();
        const int gl = C.wave >> 2, pt = C.wave & 3, g = 2 * gp + gl;
        bf16x8 af[8];
        {   const float* wrow = sw + ((size_t)g * 128 + 32 * pt + r32) * 128 + 8 * hi;
#pragma unroll
            for (int ks = 0; ks < 8; ++ks) { const f32x4 w0 = *(const f32x4*)(wrow + 16 * ks), w1 = *(const f32x4*)(wrow + 16 * ks + 4);
                u32x4 pk; pk.x = pk2(w0[0], w0[1]); pk.y = pk2(w0[2], w0[3]); pk.z = pk2(w1[0], w1[1]); pk.w = pk2(w1[2], w1[3]);
                af[ks] = __builtin_bit_cast(bf16x8, pk); } }
        float bb[16];
#pragma unroll
        for (int r = 0; r < 16; ++r) bb[r] = sb[g * 128 + 32 * pt + crow(r, hi)];
        {
            u32x4 x[8];
#pragma unroll
            for (int it = 0; it < 8; ++it) { const int e = C.tid + NTHREADS * it, q = e & 127, chunk = e >> 7;
                x[it] = *(const u32x4*)(Zc + (size_t)(tokbase + q) * 1024 + 512 + 256 * gp + 8 * chunk); }
#pragma unroll
            for (int it = 0; it < 8; ++it) {
                const int e = C.tid + NTHREADS * it, q = e & 127, chunk = e >> 7;
                const int ch0 = 256 * gp + 8 * chunk;
                const float r = rs[q];
                const f32x4 g0 = *(const f32x4*)(sng + ch0), g1 = *(const f32x4*)(sng + ch0 + 4);
                LAS bf16* dst = cvT + (8 * chunk) * QS + q;
                dst[0 * QS] = f2bf(bflo(x[it].x) * r * g0[0]); dst[1 * QS] = f2bf(bfhi(x[it].x) * r * g0[1]);
                dst[2 * QS] = f2bf(bflo(x[it].y) * r * g0[2]); dst[3 * QS] = f2bf(bfhi(x[it].y) * r * g0[3]);
                dst[4 * QS] = f2bf(bflo(x[it].z) * r * g1[0]); dst[5 * QS] = f2bf(bfhi(x[it].z) * r * g1[1]);
                dst[6 * QS] = f2bf(bflo(x[it].w) * r * g1[2]); dst[7 * QS] = f2bf(bfhi(x[it].w) * r * g1[3]);
            }
        }
        __syncthreads();
#pragma unroll 2
        for (int dt = 0; dt < 4; ++dt) {
            const int col = g * 128 + 32 * dt + r32;
            unsigned short uu[16];
#pragma unroll
            for (int r = 0; r < 16; ++r) { const size_t tok = (size_t)(tokbase + 32 * pt + crow(r, hi)); uu[r] = Zc[tok * 1024 + col]; }
            f32x16 acc = {};
            const LAS bf16* brow = cvT + (gl * 128 + 32 * dt + r32) * QS + 8 * hi;
#pragma unroll
            for (int ks = 0; ks < 8; ++ks) { const bf16x8 bfr = *(const LAS bf16x8*)(brow + 16 * ks);
                acc = __builtin_amdgcn_mfma_f32_32x32x16_bf16(af[ks], bfr, acc, 0, 0, 0); }
#pragma unroll
            for (int r = 0; r < 16; ++r) { const size_t tok = (size_t)(tokbase + 32 * pt + crow(r, hi));
                Cp[tok * 1024 + 512 + col] = f2bf(bf2f(uu[r]) * (acc[r] + bb[r])); }
        }
        __syncthreads();
    }
}
#ifndef ATT_THR
#define ATT_THR 30.0f
#endif
__device__ __forceinline__ float swapmax(float m) {
    auto rr = __builtin_amdgcn_permlane32_swap(__float_as_uint(m), __float_as_uint(m), false, false);
    float r; asm("v_max_f32_e32 %0, %1, %2" : "=v"(r) : "v"(__uint_as_float(rr[0])), "v"(__uint_as_float(rr[1]))); return r;
}
__device__ __forceinline__ float swapsum(float m) {
    auto rr = __builtin_amdgcn_permlane32_swap(__float_as_uint(m), __float_as_uint(m), false, false);
    return __uint_as_float(rr[0]) + __uint_as_float(rr[1]);
}
#define SBAR() __builtin_amdgcn_sched_barrier(0)
__device__ __forceinline__ void glds16(const void* gsrc, unsigned lds_dst) { unsigned keep;
    asm volatile("s_mov_b32 %0, m0\n\ts_mov_b32 m0, %2\n\ts_nop 0\n\tglobal_load_lds_dwordx4 %1, off\n\ts_mov_b32 m0, %0" : "=&s"(keep) : "v"(gsrc), "s"(lds_dst) : "memory"); }
#define ATT_WAIT_BAR(N) asm volatile("s_waitcnt vmcnt(" #N ") lgkmcnt(0)\n\ts_barrier" ::: "memory")
constexpr int ATT_KB = 0, ATT_VB = 3 * 16384, ATT_WS = RING_BYTES + 512;
static_assert(ATT_WS + 8 * 256 <= LDS_BYTES, "attention scratch inside LDS");
#define MFMA32(A, B, Cc) __builtin_amdgcn_mfma_f32_32x32x16_bf16(A, B, Cc, 0, 0, 0)
#define EX2(x) __builtin_amdgcn_exp2f(x)
__device__ __forceinline__ bf16x8 pack8(const f32x16& p, int b) {
    u32x4 w; w.x = pk2(p[b], p[b + 1]); w.y = pk2(p[b + 2], p[b + 3]); w.z = pk2(p[b + 4], p[b + 5]); w.w = pk2(p[b + 6], p[b + 7]);
    return __builtin_bit_cast(bf16x8, w);
}
__device__ __forceinline__ float max3f(float a, float b, float c) { float r; asm("v_max3_f32 %0, %1, %2, %3" : "=v"(r) : "v"(a), "v"(b), "v"(c)); return r; }
__device__ __forceinline__ float fadd_s(float a, float b) { float r; asm("v_add_f32_e32 %0, %1, %2" : "=v"(r) : "v"(a), "v"(b)); return r; }
#define SUM4(P, B) fadd_s(fadd_s(P[B], P[(B) + 1]), fadd_s(P[(B) + 2], P[(B) + 3]))
__device__ __forceinline__ float max2f(float a, float b) { float r; asm("v_max_f32_e32 %0, %1, %2" : "=v"(r) : "v"(a), "v"(b)); return r; }
#define ATT_STEP(P0, P1, N0, N1, TT) do { \
    const int t_ = (TT); \
      \
      \
    const int tk_ = (t_ + 3 < T) ? t_ + 3 : T - 1, tv_ = (t_ + 2 < T) ? t_ + 2 : T - 1; \
    const bf16* kn_ = Kt + (size_t)tk_ * 4096 + C.tid * 8; const bf16* vn_ = Vt + (size_t)tv_ * 8192 + C.tid * 8; \
    const LAS unsigned char* kb = lds + ATT_KB + s1 * 16384 + mapc * 8192 + hi * 1024 + r32 * 16; \
    const LAS unsigned char* vb = lds + ATT_VB + s0 * 16384 + hi * 512 + r32 * 16; \
    bf16x8 ka, kc, pw0, pw1, pw2, pw3; float sacc = 0.f; \
    ka = *(const LAS bf16x8*)(kb); kc = *(const LAS bf16x8*)(kb + 512); SBAR(); \
      \
    N0 = MFMA32(ka, qr[0], zero16); P0[0] = EX2(P0[0]); ka = *(const LAS bf16x8*)(kb + 2048); SBAR(); \
    N1 = MFMA32(kc, qr[0], zero16); P0[1] = EX2(P0[1]); kc = *(const LAS bf16x8*)(kb + 2048 + 512); SBAR(); \
    N0 = MFMA32(ka, qr[1], N0); P0[2] = EX2(P0[2]); ka = *(const LAS bf16x8*)(kb + 4096); SBAR(); \
    N1 = MFMA32(kc, qr[1], N1); P0[3] = EX2(P0[3]); kc = *(const LAS bf16x8*)(kb + 4096 + 512); SBAR(); \
    N0 = MFMA32(ka, qr[2], N0); P0[4] = EX2(P0[4]); sacc = fadd_s(sacc, SUM4(P0, 0)); ka = *(const LAS bf16x8*)(kb + 6144); SBAR(); \
    N1 = MFMA32(kc, qr[2], N1); P0[5] = EX2(P0[5]); kc = *(const LAS bf16x8*)(kb + 6144 + 512); SBAR(); \
    bf16x8 v0 = *(const LAS bf16x8*)(vb), v1 = *(const LAS bf16x8*)(vb + 4096), v2 = *(const LAS bf16x8*)(vb + 8192), v3 = *(const LAS bf16x8*)(vb + 12288); \
    N0 = MFMA32(ka, qr[3], N0); P0[6] = EX2(P0[6]); SBAR(); \
    N1 = MFMA32(kc, qr[3], N1); P0[7] = EX2(P0[7]); pw0 = pack8(P0, 0); SBAR(); \
    o[0] = MFMA32(pw0, v0, o[0]); P0[8] = EX2(P0[8]); P0[9] = EX2(P0[9]); sacc = fadd_s(sacc, SUM4(P0, 4)); v0 = *(const LAS bf16x8*)(vb + 1024); SBAR(); \
    o[1] = MFMA32(pw0, v1, o[1]); P0[10] = EX2(P0[10]); P0[11] = EX2(P0[11]); v1 = *(const LAS bf16x8*)(vb + 4096 + 1024); SBAR(); \
    o[2] = MFMA32(pw0, v2, o[2]); P0[12] = EX2(P0[12]); P0[13] = EX2(P0[13]); sacc = fadd_s(sacc, SUM4(P0, 8)); v2 = *(const LAS bf16x8*)(vb + 8192 + 1024); SBAR(); \
    o[3] = MFMA32(pw0, v3, o[3]); P0[14] = EX2(P0[14]); P0[15] = EX2(P0[15]); pw1 = pack8(P0, 8); v3 = *(const LAS bf16x8*)(vb + 12288 + 1024); SBAR(); \
    o[0] = MFMA32(pw1, v0, o[0]); P1[0] = EX2(P1[0]); P1[1] = EX2(P1[1]); sacc = fadd_s(sacc, SUM4(P0, 12)); v0 = *(const LAS bf16x8*)(vb + 2048); SBAR(); \
    o[1] = MFMA32(pw1, v1, o[1]); P1[2] = EX2(P1[2]); P1[3] = EX2(P1[3]); v1 = *(const LAS bf16x8*)(vb + 4096 + 2048); SBAR(); \
    o[2] = MFMA32(pw1, v2, o[2]); P1[4] = EX2(P1[4]); P1[5] = EX2(P1[5]); sacc = fadd_s(sacc, SUM4(P1, 0)); v2 = *(const LAS bf16x8*)(vb + 8192 + 2048); SBAR(); \
    o[3] = MFMA32(pw1, v3, o[3]); P1[6] = EX2(P1[6]); P1[7] = EX2(P1[7]); pw2 = pack8(P1, 0); v3 = *(const LAS bf16x8*)(vb + 12288 + 2048); SBAR(); \
    o[0] = MFMA32(pw2, v0, o[0]); P1[8] = EX2(P1[8]); P1[9] = EX2(P1[9]); sacc = fadd_s(sacc, SUM4(P1, 4)); v0 = *(const LAS bf16x8*)(vb + 3072); SBAR(); \
    o[1] = MFMA32(pw2, v1, o[1]); P1[10] = EX2(P1[10]); P1[11] = EX2(P1[11]); v1 = *(const LAS bf16x8*)(vb + 4096 + 3072); SBAR(); \
    o[2] = MFMA32(pw2, v2, o[2]); P1[12] = EX2(P1[12]); P1[13] = EX2(P1[13]); sacc = fadd_s(sacc, SUM4(P1, 8)); v2 = *(const LAS bf16x8*)(vb + 8192 + 3072); SBAR(); \
    o[3] = MFMA32(pw2, v3, o[3]); P1[14] = EX2(P1[14]); P1[15] = EX2(P1[15]); pw3 = pack8(P1, 8); v3 = *(const LAS bf16x8*)(vb + 12288 + 3072); SBAR(); \
    o[0] = MFMA32(pw3, v0, o[0]); sacc = fadd_s(sacc, SUM4(P1, 12)); glds16(kn_, (unsigned)__builtin_amdgcn_readfirstlane(ldsw + ATT_KB + s0 * 16384)); SBAR(); \
    o[1] = MFMA32(pw3, v1, o[1]); glds16(kn_ + 256 * 4096, (unsigned)__builtin_amdgcn_readfirstlane(ldsw + ATT_KB + s0 * 16384 + 8192)); SBAR(); \
    o[2] = MFMA32(pw3, v2, o[2]); glds16(vn_, (unsigned)__builtin_amdgcn_readfirstlane(ldsw + ATT_VB + s2 * 16384)); SBAR(); \
    o[3] = MFMA32(pw3, v3, o[3]); glds16(vn_ + 4096, (unsigned)__builtin_amdgcn_readfirstlane(ldsw + ATT_VB + s2 * 16384 + 8192)); \
    lsum = fadd_s(lsum, sacc); \
    if (!nomax) {       \
        float ra = max3f(N0[0], N0[1], N0[2]), rb = max3f(N1[0], N1[1], N1[2]); \
        _Pragma("unroll") for (int r = 3; r < 15; r += 2) { ra = max3f(ra, N0[r], N0[r + 1]); rb = max3f(rb, N1[r], N1[r + 1]); } \
        ra = max3f(ra, N0[15], N1[15]); \
        const float rm = swapmax(max2f(ra, rb)) - mhat; \
        if (shifted) { _Pragma("unroll") for (int r = 0; r < 16; ++r) { N0[r] -= mhat; N1[r] -= mhat; } } \
        if (t_ + 1 < T && __any(rm > ATT_THR)) { \
            shifted = true; \
            const float dl = fmaxf(rm, 0.f); mhat += dl; \
            _Pragma("unroll") for (int r = 0; r < 16; ++r) { N0[r] -= dl; N1[r] -= dl; } \
            const float f = EX2(-dl); lsum *= f; \
            if (hi == 0) wsf[r32] = f; \
            asm volatile("s_waitcnt lgkmcnt(0)" ::: "memory"); \
            _Pragma("unroll") for (int r = 0; r < 16; ++r) { const float fr = wsf[crow(r, hi)]; \
                _Pragma("unroll") for (int db = 0; db < 4; ++db) o[db][r] *= fr; } \
        } \
    } \
    ATT_WAIT_BAR(4); \
    { const int tmp_ = s0; s0 = s1; s1 = s2; s2 = tmp_; } \
} while (0)

__device__ __forceinline__ void attn_unit(const Ctx& C, const bf16* Zqkv, const bf16* Kp, const bf16* Vp, const bf16* Zbg, bf16* Bp, const float* sg, float lam, float omli, int h, int qrow0, int seqlen, const unsigned* knmax) {
    const int r32 = C.lane & 31, hi = C.lane >> 5;
    const int mapc = C.wave >> 2, wq = C.wave & 3;
    const int T = seqlen / 64, kt0 = (qrow0 / seqlen) * T;
    const bf16* Kt = Kp + (size_t)((2 * h) * 256 + kt0) * 4096;
    const bf16* Vt = Vp + (size_t)(h * 256 + kt0) * 8192;
    LAS unsigned char* lds = C.lds;
    LAS float* wsf = (LAS float*)(lds + ATT_WS) + C.wave * 64;
    const unsigned ldsw = (unsigned)(uintptr_t)lds + (unsigned)C.wave * 1024u;
    { const bf16* kn = Kt + C.tid * 8; const bf16* vn = Vt + C.tid * 8;
#pragma unroll
      for (int s = 0; s < 3; ++s) { glds16(kn + s * 4096, (unsigned)__builtin_amdgcn_readfirstlane(ldsw + ATT_KB + s * 16384));
                                    glds16(kn + 256 * 4096 + s * 4096, (unsigned)__builtin_amdgcn_readfirstlane(ldsw + ATT_KB + s * 16384 + 8192)); }
#pragma unroll
      for (int s = 0; s < 2; ++s) { glds16(vn + s * 8192, (unsigned)__builtin_amdgcn_readfirstlane(ldsw + ATT_VB + s * 16384));
                                    glds16(vn + s * 8192 + 4096, (unsigned)__builtin_amdgcn_readfirstlane(ldsw + ATT_VB + s * 16384 + 8192)); } }
    bf16x8 qr[4];
    { const bf16* qp = Zqkv + (size_t)(qrow0 + 32 * wq + r32) * 1024 + (2 * h + mapc) * 64 + 8 * hi;
#pragma unroll
      for (int d0 = 0; d0 < 4; ++d0) qr[d0] = *(const bf16x8*)(qp + 16 * d0); }
    bool nomax;
    {   float qn2 = 0.f;
#pragma unroll
        for (int d0 = 0; d0 < 4; ++d0) { const u32x4 w = __builtin_bit_cast(u32x4, qr[d0]);
            qn2 += bflo(w.x) * bflo(w.x) + bfhi(w.x) * bfhi(w.x) + bflo(w.y) * bflo(w.y) + bfhi(w.y) * bfhi(w.y)
                 + bflo(w.z) * bflo(w.z) + bfhi(w.z) * bfhi(w.z) + bflo(w.w) * bflo(w.w) + bfhi(w.w) * bfhi(w.w); }
        qn2 = swapsum(qn2);
        const float kn2 = __uint_as_float(knmax[(qrow0 / seqlen) * 16 + 2 * h + mapc]);
        nomax = !__any(qn2 * kn2 * 1.1f > ATT_THR * ATT_THR);
    }
    ATT_WAIT_BAR(0);
    int s0 = 0, s1 = 1, s2 = 2;
    f32x16 o[4];
#pragma unroll
    for (int db = 0; db < 4; ++db) o[db] = f32x16{};
    const f32x16 zero16 = f32x16{};
    float mhat = 0.f, lsum = 0.f; bool shifted = false;
    f32x16 pA0, pA1, pB0, pB1;
    {
        const LAS unsigned char* kb = lds + ATT_KB + mapc * 8192 + hi * 1024 + r32 * 16;
        pA0 = f32x16{}; pA1 = f32x16{};
#pragma unroll
        for (int d0 = 0; d0 < 4; ++d0) {
            const bf16x8 k0 = *(const LAS bf16x8*)(kb + d0 * 2048), k1 = *(const LAS bf16x8*)(kb + d0 * 2048 + 512);
            pA0 = MFMA32(k0, qr[d0], pA0); pA1 = MFMA32(k1, qr[d0], pA1);
        }
        float rm = fmaxf(pA0[0], pA1[0]);
#pragma unroll
        for (int r = 1; r < 16; ++r) rm = fmaxf(rm, fmaxf(pA0[r], pA1[r]));
        rm = swapmax(rm);
        mhat = (fabsf(rm) <= ATT_THR) ? 0.f : rm;
        shifted = __any(mhat != 0.f);
        if (shifted) {
#pragma unroll
            for (int r = 0; r < 16; ++r) { pA0[r] -= mhat; pA1[r] -= mhat; } }
    }
    asm volatile("s_waitcnt lgkmcnt(0)\n\ts_barrier" ::: "memory");
    if (mapc != 0) __builtin_amdgcn_s_setprio(1);
#pragma unroll 1
    for (int t = 0; t < T; t += 2) {
        ATT_STEP(pA0, pA1, pB0, pB1, t);
        ATT_STEP(pB0, pB1, pA0, pA1, t + 1);
    }
    __builtin_amdgcn_s_setprio(0);
    ATT_WAIT_BAR(0);
    lsum = swapsum(lsum);
    if (hi == 0) wsf[32 + r32] = 1.0f / lsum;
    asm volatile("s_waitcnt lgkmcnt(0)" ::: "memory");
    {   LAS float* st = (LAS float*)lds + (size_t)mapc * 16384 + (32 * wq) * 128 + r32;
#pragma unroll
        for (int r = 0; r < 16; ++r) { const int q = crow(r, hi); const float il = wsf[32 + q];
#pragma unroll
            for (int db = 0; db < 4; ++db) st[q * 128 + 32 * db] = o[db][r] * il; } }
    __syncthreads();
    {   const LAS float* O1 = (const LAS float*)lds; const LAS float* O2 = O1 + 16384;
        const int pc = C.tid & 15;
        const f32x4 g0 = *(const f32x4*)(sg + 8 * pc), g1 = *(const f32x4*)(sg + 8 * pc + 4);
        u32x4 gw4[4];
#pragma unroll
        for (int k = 0; k < 4; ++k) gw4[k] = *(const u32x4*)(Zbg + (size_t)(qrow0 + (C.tid >> 4) + 32 * k) * 1024 + h * 128 + 8 * pc);
#pragma unroll
        for (int k = 0; k < 4; ++k) {
            const int row = (C.tid >> 4) + 32 * k; const size_t tok = (size_t)(qrow0 + row);
            const u32x4 gw = gw4[k];
            const f32x4 a0 = *(const LAS f32x4*)(O1 + row * 128 + 8 * pc), a1 = *(const LAS f32x4*)(O1 + row * 128 + 8 * pc + 4);
            const f32x4 b0 = *(const LAS f32x4*)(O2 + row * 128 + 8 * pc), b1 = *(const LAS f32x4*)(O2 + row * 128 + 8 * pc + 4);
            float v[8];
            v[0] = a0[0] - lam * b0[0]; v[1] = a0[1] - lam * b0[1]; v[2] = a0[2] - lam * b0[2]; v[3] = a0[3] - lam * b0[3];
            v[4] = a1[0] - lam * b1[0]; v[5] = a1[1] - lam * b1[1]; v[6] = a1[2] - lam * b1[2]; v[7] = a1[3] - lam * b1[3];
            float ss = 0.f;
#pragma unroll
            for (int i = 0; i < 8; ++i) ss += v[i] * v[i];
            ss += __shfl_xor(ss, 1); ss += __shfl_xor(ss, 2); ss += __shfl_xor(ss, 4); ss += __shfl_xor(ss, 8);
            const float rstd = rsqrtf(ss * (1.0f / 128) + RMS_EPS) * omli;
            u32x4 w;
            w.x = pk2(v[0] * rstd * g0[0] * siluf_(bflo(gw.x)), v[1] * rstd * g0[1] * siluf_(bfhi(gw.x)));
            w.y = pk2(v[2] * rstd * g0[2] * siluf_(bflo(gw.y)), v[3] * rstd * g0[3] * siluf_(bfhi(gw.y)));
            w.z = pk2(v[4] * rstd * g1[0] * siluf_(bflo(gw.z)), v[5] * rstd * g1[1] * siluf_(bfhi(gw.z)));
            w.w = pk2(v[6] * rstd * g1[2] * siluf_(bflo(gw.w)), v[7] * rstd * g1[3] * siluf_(bfhi(gw.w)));
            *(u32x4*)(Bp + tok * 1024 + h * 128 + 8 * pc) = w;
        }
    }
    __syncthreads();
}
__device__ __forceinline__ void phase_attn(const Ctx& C, const bf16* Zqkv, const bf16* Kp, const bf16* Vp, const bf16* Zbg, bf16* Bp,
                                           const float* lq1, const float* lk1, const float* lq2, const float* lk2, const float* sg, int layer, int seqlen, const unsigned* knmax) {
    float d1 = 0.f, d2 = 0.f;
    for (int i = 0; i < 64; ++i) { d1 += lq1[i] * lk1[i]; d2 += lq2[i] * lk2[i]; }
    const float lam_init = 0.8f - 0.6f * expf(-0.3f * (float)layer);
    const float lam = expf(d1) - expf(d2) + lam_init;
    if (C.G == 256) {
        const int h = C.b & 7, slot = C.b >> 3;
        for (int i = 0; i < 4; ++i) attn_unit(C, Zqkv, Kp, Vp, Zbg, Bp, sg, lam, 1.0f - lam_init, h, (i * 32 + slot) * 128, seqlen, knmax);
    } else {
        for (int u = C.b; u < 1024; u += C.G) attn_unit(C, Zqkv, Kp, Vp, Zbg, Bp, sg, lam, 1.0f - lam_init, u & 7, (u >> 3) * 128, seqlen, knmax);
    }
}
#define XB_TMO      128
#define XB_XCNT(j)  (256  + 64 * (j))
#define XB_XSUB(j)  (1280 + 64 * (j))
#define XB_XGEN(j)  (2304 + 64 * (j))
#define XB_TOP      3328
#define XB_TOPGEN   3392
#define XCD_BAR_WORDS 3456
#define XB_SPIN_CAP (1u << 22)

__device__ __forceinline__ unsigned xb_ld(unsigned* p)              { return __hip_atomic_load(p, __ATOMIC_RELAXED, __HIP_MEMORY_SCOPE_AGENT); }
__device__ __forceinline__ unsigned xb_add(unsigned* p, unsigned v) { return __hip_atomic_fetch_add(p, v, __ATOMIC_RELAXED, __HIP_MEMORY_SCOPE_AGENT); }
__device__ __forceinline__ unsigned xb_xcc_id() { return (unsigned)__builtin_amdgcn_s_getreg((3 << 11) | 20) & 0xFu; }
#define XB_SPIN(cond, bar) do { unsigned _sp = 0; while (cond) { __builtin_amdgcn_s_sleep(1); \
    if ((++_sp & 255u) == 0u) { if (xb_ld(&(bar)[XB_TMO])) break; if (_sp > XB_SPIN_CAP) { atomicAdd(&(bar)[XB_TMO], 1u); break; } } } } while (0)

struct XcdBarrier {
    unsigned* bar; unsigned x;
    volatile LAS unsigned* st;
};

__device__ __forceinline__ XcdBarrier xcd_barrier_post(unsigned* bar, volatile LAS unsigned* st) {
    XcdBarrier b; b.bar = bar; b.x = xb_xcc_id(); b.st = st;
    if (threadIdx.x == 0) (void)xb_add(&bar[XB_XCNT(b.x)], 1u);
    return b;
}
__device__ __forceinline__ void xcd_barrier_complete(unsigned* bar, unsigned x, unsigned& nloc, unsigned& nx) {
    const unsigned G = gridDim.x * gridDim.y * gridDim.z;
    unsigned sum, cnt, mine, sp = 0u;
    for (;;) {
        sum = 0u; cnt = 0u; mine = 0u;
#pragma unroll
        for (unsigned j = 0; j < 16; ++j) { const unsigned c = xb_ld(&bar[XB_XCNT(j)]); sum += c; cnt += (c > 0u) ? 1u : 0u; mine = (j == x) ? c : mine; }
        if (sum == G) break;
        __builtin_amdgcn_s_sleep(1);
        if ((++sp & 255u) == 0u) { if (xb_ld(&bar[XB_TMO])) break; if (sp > XB_SPIN_CAP) { atomicAdd(&bar[XB_TMO], 1u); break; } }
    }
    nloc = mine > 0u ? mine : 1u; nx = cnt > 0u ? cnt : 1u;
}

__device__ __forceinline__ void xcd_barrier(const XcdBarrier& b) {
    asm volatile("s_waitcnt vmcnt(0)" ::: "memory");
    __syncthreads();
    if (threadIdx.x == 0) {
        unsigned* bar = b.bar;
        __builtin_amdgcn_s_waitcnt(0);
        unsigned nloc = b.st[0], nx = b.st[1];
        if (nloc == 0u) { xcd_barrier_complete(bar, b.x, nloc, nx); b.st[0] = nloc; b.st[1] = nx; }
        const unsigned old = xb_add(&bar[XB_XSUB(b.x)], 1u);
        const unsigned gen = old / nloc;
        if (old + 1u == (gen + 1u) * nloc) {
            __builtin_amdgcn_fence(__ATOMIC_RELEASE, "agent");
            asm volatile("s_waitcnt vmcnt(0)" ::: "memory");
            const unsigned og = xb_add(&bar[XB_TOP], 1u);
            const unsigned tg = og / nx;
            if (og + 1u == (tg + 1u) * nx) xb_add(&bar[XB_TOPGEN], 1u);
            else XB_SPIN(xb_ld(&bar[XB_TOPGEN]) == tg, bar);
            __builtin_amdgcn_fence(__ATOMIC_ACQUIRE, "agent");
            xb_add(&bar[XB_XGEN(b.x)], 1u);
            asm volatile("s_waitcnt vmcnt(0)" ::: "memory");
        } else {
            XB_SPIN(xb_ld(&bar[XB_XGEN(b.x)]) == gen, bar);
            __builtin_amdgcn_fence(__ATOMIC_ACQUIRE, "agent");
            asm volatile("s_waitcnt vmcnt(0)" ::: "memory");
        }
    }
    __syncthreads();
}
constexpr size_t WS_BAR = 0;
constexpr int LDS_ST = LDS_TAB + 256;
constexpr int PH_PER_GROUP = 8, N_PHASES = 1 + NGROUPS * PH_PER_GROUP;
__global__ void __launch_bounds__(NTHREADS, 2) fwd_kernel(Params p) {
    extern __shared__ __attribute__((aligned(16))) unsigned char lds_raw[];
    { const int t0 = threadIdx.x; if (t0 == 0) { LAS double* tab = (LAS double*)((LAS unsigned char*)lds_raw + LDS_TAB);
#pragma unroll
        for (int i = 0; i < 32; ++i) tab[i] = p.invrev[i]; } }
    if (blockIdx.x == 0) { unsigned* bw = (unsigned*)(p.ws + WS_BAR); for (int i = threadIdx.x; i < XCD_BAR_WORDS; i += NTHREADS) bw[i] = 0u; }
    if (blockIdx.x == 0 && threadIdx.x < 384) ((unsigned*)(p.ws + WS_PCNT))[threadIdx.x] = 0u;
    if (threadIdx.x < 2) ((volatile LAS unsigned*)((LAS unsigned char*)lds_raw + LDS_ST))[threadIdx.x] = 0u;
    __syncthreads();
    XcdBarrier bar; bar.bar = (unsigned*)(p.ws + WS_BAR); bar.x = 0; bar.st = (volatile LAS unsigned*)((LAS unsigned char*)lds_raw + LDS_ST);
    for (int ph = p.ph_lo; ph < p.ph_hi; ++ph) {
        int tid_ = threadIdx.x; asm volatile("" : "+v"(tid_));
        int bid_ = blockIdx.x; asm volatile("" : "+s"(bid_));
        size_t wz_ = 0; asm volatile("" : "+s"(wz_));
        unsigned char* ws = p.ws + wz_;
        Ctx C; C.lds = (LAS unsigned char*)lds_raw; C.tid = tid_; C.lane = C.tid & 63; C.wave = __builtin_amdgcn_readfirstlane(C.tid >> 6); C.G = gridDim.x; C.b = bid_;
        bf16* R1 = (bf16*)(ws + WS_R1); bf16* Zqkv = (bf16*)(ws + WS_ZQKV); bf16* Kp = (bf16*)(ws + WS_ZQKV + 32 * MiB); bf16* Za = (bf16*)(ws + WS_ZA); bf16* Zc = (bf16*)(ws + WS_ZC);
        bf16* Zbg = (bf16*)(ws + WS_ZBG); bf16* Zm = (bf16*)(ws + WS_ZM); bf16* Ap = (bf16*)(ws + WS_AP); bf16* Cp = Ap; bf16* Vp = (bf16*)(ws + WS_VP);
        bf16* Bp = (bf16*)(ws + WS_ZQKV + 64 * MiB);
        if (ph == 0) {
            phase_weights(C, p);
            __syncthreads();
            phase_norm_in(C, p.in[0], p.in[2], R1, (unsigned*)(ws + WS_KNMAX));
        }
        else {
            const int k = ph - 1, gi = k / PH_PER_GROUP, r = k % PH_PER_GROUP;
            const int seqlen = gi == 0 ? 16384 : 2048;
            float* xout = p.out + (size_t)gi * GT * DM;
            {
                const int l = r >> 2, s = (r & 3) + 1;
                const float* xin = l == 0 ? (gi == 0 ? p.in[0] : p.in[1] + (size_t)(gi - 1) * GT * DM) : xout;
                if (false) { }
                else if (s == 1) {
                    pg8::Gemm g{(l == 0 && gi > 0) ? Bp : R1, (const bf16*)(ws + WS_WIN) + (size_t)l * INC * 1024, GT, INC, 1024}; pg8::StaticOrder S; S.init(GT, INC, C.G, C.b);
                    EpiZ E{Zqkv, Kp, Vp, Za, Zc, Zbg, Zm, (const LAS double*)(C.lds + LDS_TAB), seqlen, (unsigned*)(ws + WS_KNMAX)};
#ifndef DIS_G1
                    pg8::gemm_phase<EpiZ, pg8::StaticOrder, true, true>(C.lds, g, S, E, C.tid);
#endif
                } else if (s == 2) {
#ifndef DIS_CONV
                    phase_conv(C, Za, Ap, p.in[4] + l * 31 * 512, p.in[5] + l * 512, p.in[6] + l * 512, seqlen);
#endif
                    __syncthreads();
#ifndef DIS_SGU
                    phase_sgu(C, Zc, Cp, p.in[14] + l * 512, p.in[15] + (size_t)l * 4 * 128 * 128, p.in[16] + l * 512);
#endif
                    __syncthreads();
#ifndef DIS_ATT
 phase_attn(C, Zqkv, Kp, Vp, Zbg, Bp, p.in[8] + l * 64, p.in[9] + l * 64, p.in[10] + l * 64, p.in[11] + l * 64, p.in[12] + l * 128, l, seqlen, (const unsigned*)(ws + WS_KNMAX));
#endif
                }
                else if (s == 3) {
                    SegOrder S; S.so.init(GT, DM, C.G, C.b); S.AC = Ap; S.B = Bp; S.WAC = (const bf16*)(ws + WS_WAC) + (size_t)l * 1024 * 1024; S.WB = (const bf16*)(ws + WS_WB) + (size_t)l * 1024 * 1024;
                    pg8::Gemm g{Ap, S.WAC, GT, DM, 1024};
                    EpiGate3 E{Zm, R1};
#ifndef DIS_G5
                    pg8::gemm_phase_seg<EpiGate3, SegOrder, true, true>(C.lds, g, S, E, C.tid);
#endif
                } else {
                    pg8::Gemm g{R1, (const bf16*)(ws + WS_WO) + (size_t)l * 1024 * 1024, GT, DM, 1024}; pg8::StaticOrder S; S.init(GT, DM, C.G, C.b);
                    EpiResNorm E{xin, xout, l == 0 ? R1 : nullptr, l == 0 ? p.in[2] + DM : p.in[19], (unsigned*)(ws + WS_SLOTS), (unsigned*)(ws + WS_PCNT) + (gi * 2 + l) * 64};
                    pg8::gemm_phase<EpiResNorm, pg8::StaticOrder, false, true>(C.lds, g, S, E, C.tid);
                    if (l == 0 && C.b == 0 && C.tid < 128) ((unsigned*)(ws + WS_KNMAX))[C.tid] = 0u;
                    if (l == 1 && gi + 1 < NGROUPS) {
                        __syncthreads();
                        phase_norm_in(C, p.in[1] + (size_t)gi * GT * DM, p.in[2], Bp, (unsigned*)(ws + WS_KNMAX));
                    }
                }
            }
        }
        if (ph + 1 < p.ph_hi) {
            if (ph == p.ph_lo) { cg::this_grid().sync(); bar = xcd_barrier_post((unsigned*)(p.ws + WS_BAR), (volatile LAS unsigned*)((LAS unsigned char*)lds_raw + LDS_ST)); }
            else xcd_barrier(bar);
        }
    }
}


#ifndef ONE_LAUNCH
#define ONE_LAUNCH 1
#endif
extern "C" void kernel_launch(void* const* d_in, const int* in_sizes, int n_in, void* d_out, int out_size, void* d_ws, size_t ws_size, hipStream_t stream) {
    static int grid = 0;
    if (grid == 0) {
        if (n_in != 20 || out_size != 3 * GT * DM || ws_size < WS_END) { fprintf(stderr, "kernel_launch: unexpected shapes n_in %d out %d ws %zu\n", n_in, out_size, ws_size); grid = -1; return; }
        int dev = 0, cus = 0, per_cu = 0;
        hipGetDevice(&dev); hipDeviceGetAttribute(&cus, hipDeviceAttributeMultiprocessorCount, dev);
        hipFuncSetAttribute((const void*)fwd_kernel, hipFuncAttributeMaxDynamicSharedMemorySize, LDS_BYTES);
        hipOccupancyMaxActiveBlocksPerMultiprocessor(&per_cu, (const void*)fwd_kernel, NTHREADS, LDS_BYTES);
        if (per_cu < 1) { fprintf(stderr, "kernel_launch: occupancy query says %d blocks per CU\n", per_cu); per_cu = 1; }
        if (cus != 256) { fprintf(stderr, "kernel_launch: built for a 256-CU device (got %d CUs); nothing launched\n", cus); grid = -1; return; }
        grid = cus * 1;
        (void)hipGetLastError();
    }
    if (grid < 0) return;
    Params p{};
    for (int i = 0; i < 20; ++i) p.in[i] = (const float*)d_in[i];
    p.out = (float*)d_out; p.ws = (unsigned char*)d_ws;
    for (int i = 0; i < 32; ++i) p.invrev[i] = pow(10000.0, -(double)i / 32.0) / (2.0 * M_PI);
#if ONE_LAUNCH
    p.ph_lo = 0; p.ph_hi = N_PHASES;
    void* args[] = {&p};
    hipError_t e = hipLaunchCooperativeKernel((const void*)fwd_kernel, dim3(grid), dim3(NTHREADS), args, LDS_BYTES, stream);
    if (e != hipSuccess) fprintf(stderr, "cooperative launch failed: %s (grid %d)\n", hipGetErrorString(e), grid);
#ifdef PROBE_T
    for (int rep = 0; rep < PROBE_N; ++rep) {
        if (PROBE_T == 8) { hipFuncSetAttribute((const void*)probe_kernel<PROBE_T>, hipFuncAttributeMaxDynamicSharedMemorySize, LDS_BYTES); hipLaunchCooperativeKernel((const void*)probe_kernel<PROBE_T>, dim3(grid), dim3(NTHREADS), args, LDS_BYTES, stream); }
        else hipLaunchKernelGGL(probe_kernel<PROBE_T>, dim3(grid), dim3(NTHREADS), LDS_BYTES, stream, p);
    }
#endif
#else
    for (int ph = 0; ph < N_PHASES; ++ph) { p.ph_lo = ph; p.ph_hi = ph + 1; hipLaunchKernelGGL(fwd_kernel, dim3(grid), dim3(NTHREADS), LDS_BYTES, stream, p); }
#endif
}
```
